# Optimizing an MI355X kernel written in HIP

```python
import jax, jax.numpy as jnp
from jax import lax
import numpy as np

D_MODEL = 1024
BATCH = 8
SEQ = 8192
DEPTH = 1
DEC_BATCH = 8
DEC_SEQ = 4096
PAST_LEN = 128

D_MIX = 2 * D_MODEL
D_POOL = D_MIX // 2
D_RET = D_MIX - D_POOL
POOL_WINDOWS = (2, 4, 8, 16)
N_POOL_GROUPS = len(POOL_WINDOWS)
POOL_GROUP = D_POOL // N_POOL_GROUPS
N_RET_HEADS = 8
RET_HEAD_DIM = D_RET // N_RET_HEADS
CHUNK = 128
ROPE_BASE = 10000.0
NORM_EPS = 1e-6
D_IN = D_POOL + 3 * D_RET + D_MIX

kernel_name = "hybrid_pool_retention_encoder"


def rms_norm(x, g):
    xf = x.astype(jnp.float32)
    y = xf * lax.rsqrt(jnp.mean(xf * xf, axis=-1, keepdims=True) + NORM_EPS)
    return (y * g.astype(jnp.float32)).astype(x.dtype)


def multiscale_pool(u, w_grp, scale):
    B, S, _ = u.shape
    uf = u.astype(jnp.float32).reshape(B, S, N_POOL_GROUPS, POOL_GROUP)
    cs = jnp.concatenate([jnp.zeros((B, 1, N_POOL_GROUPS, POOL_GROUP), jnp.float32),
                          jnp.cumsum(uf, axis=1)], axis=1)
    t = np.arange(S)
    outs = []
    for g, w in enumerate(POOL_WINDOWS):
        lo = np.clip(t - w // 2, 0, S)
        hi = np.clip(t + w // 2, 0, S)
        csg = cs[:, :, g]
        win_sum = jnp.take(csg, hi, axis=1) - jnp.take(csg, lo, axis=1)
        mean = win_sum / jnp.asarray(hi - lo, jnp.float32)[None, :, None]
        outs.append(mean - uf[:, :, g])
    p = jnp.stack(outs, axis=2)
    p = jnp.einsum('bsgc,gcd->bsgd', p, w_grp.astype(jnp.float32)).reshape(B, S, D_POOL)
    return p * scale.astype(jnp.float32)


def rope(x, pos):
    half = x.shape[-1] // 2
    freqs = ROPE_BASE ** (-jnp.arange(half, dtype=jnp.float32) / half)
    ang = pos[:, None] * freqs[None, :]
    cos, sin = jnp.cos(ang), jnp.sin(ang)
    x1, x2 = x[..., :half], x[..., half:]
    return jnp.concatenate([x1 * cos - x2 * sin, x2 * cos + x1 * sin], axis=-1)


def log_decay(a):
    return jnp.log1p(-jnp.exp2(-a.astype(jnp.float32)))


def chunk_retention(q, k, v, log_gamma, strict):
    B, H, S, d = q.shape
    n = S // CHUNK
    to_chunks = lambda t: jnp.moveaxis(t.reshape(B, H, n, CHUNK, d), 2, 0)
    idx = jnp.arange(CHUNK, dtype=jnp.float32)
    diff = idx[:, None] - idx[None, :]
    mask = diff > 0 if strict else diff >= 0
    lg = log_gamma[:, None, None]
    D = jnp.where(mask[None], jnp.exp(jnp.where(mask, diff, 0.0)[None] * lg), 0.0)
    q_decay = jnp.exp((idx + 1.0)[None, :] * log_gamma[:, None])[..., None]
    k_decay = jnp.exp((CHUNK - 1.0 - idx)[None, :] * log_gamma[:, None])[..., None]
    chunk_decay = jnp.exp(CHUNK * log_gamma)[:, None, None]

    def step(state, inp):
        qc, kc, vc = inp
        inner = jnp.einsum('bhid,bhjd->bhij', qc, kc) * D
        o = (jnp.einsum('bhij,bhjv->bhiv', inner, vc)
             + jnp.einsum('bhid,bhdv->bhiv', qc * q_decay, state))
        state = state * chunk_decay + jnp.einsum('bhjd,bhjv->bhdv', kc * k_decay, vc)
        return state, o

    state0 = jnp.zeros((B, H, d, d), jnp.float32)
    _, o = lax.scan(step, state0, (to_chunks(q), to_chunks(k), to_chunks(v)))
    return jnp.moveaxis(o, 0, 2).reshape(B, H, S, d)


def bidir_retention(q, k, v, dec_f, dec_b):
    B, S, _ = q.shape
    heads = lambda t: t.reshape(B, S, N_RET_HEADS, RET_HEAD_DIM).transpose(0, 2, 1, 3).astype(jnp.float32)
    pos = jnp.arange(S, dtype=jnp.float32)
    qh = rope(heads(q), pos)
    kh = rope(heads(k), pos) * (RET_HEAD_DIM ** -0.5)
    vh = heads(v)
    rev = lambda t: jnp.flip(t, axis=2)
    o_f = chunk_retention(qh, kh, vh, log_decay(dec_f), strict=False)
    o_b = rev(chunk_retention(rev(qh), rev(kh), rev(vh), log_decay(dec_b), strict=True))
    o = o_f + o_b
    mu = jnp.mean(o, axis=-1, keepdims=True)
    var = jnp.mean(jnp.square(o - mu), axis=-1, keepdims=True)
    o = (o - mu) * lax.rsqrt(var + NORM_EPS)
    return o.transpose(0, 2, 1, 3).reshape(B, S, D_RET)


def encoder_layer(x, c, ada_w, ada_b, g_pre, g_post, w_in, pool_w, pool_scale, dec_f, dec_b, w_out):
    mod = jnp.einsum('bd,de->be', jax.nn.silu(c), ada_w) + ada_b
    shift, scale, gate = jnp.split(mod, 3, axis=-1)
    h = rms_norm(x, g_pre) * (1.0 + scale[:, None, :]) + shift[:, None, :]
    proj = jnp.einsum('bsd,de->bse', h, w_in)
    u_pool, q, k, v, z = jnp.split(
        proj, [D_POOL, D_POOL + D_RET, D_POOL + 2 * D_RET, D_POOL + 3 * D_RET], axis=-1)
    y_pool = multiscale_pool(u_pool, pool_w, pool_scale)
    y_ret = bidir_retention(q, k, v, dec_f, dec_b)
    y = jnp.concatenate([y_pool, y_ret], axis=-1) * jax.nn.silu(z.astype(jnp.float32))
    out = jnp.einsum('bse,ed->bsd', y.astype(x.dtype), w_out)
    return x + gate[:, None, :] * rms_norm(out, g_post)


def setup_inputs(seed: int = 0) -> dict:
    key = jax.random.key(seed)
    ks = jax.random.split(key, 16)
    f32 = jnp.float32
    nrm = lambda k, shape, s: jax.random.normal(k, shape, f32) * s
    base_decay = 5.0 + jnp.arange(N_RET_HEADS, dtype=f32)
    return {
        "x_prompt": nrm(ks[0], (BATCH, SEQ, D_MODEL), 1.0),
        "x_sample": nrm(ks[1], (DEC_BATCH, DEC_SEQ, D_MODEL), 1.0),
        "c_prompt": nrm(ks[2], (BATCH, D_MODEL), 1.0),
        "c_sample": nrm(ks[3], (DEC_BATCH, D_MODEL), 1.0),
        "ada_w": nrm(ks[4], (DEPTH, D_MODEL, 3 * D_MODEL), D_MODEL ** -0.5),
        "ada_b": nrm(ks[5], (DEPTH, 3 * D_MODEL), 0.02),
        "norm_pre": 1.0 + nrm(ks[6], (DEPTH, D_MODEL), 0.02),
        "norm_post": 1.0 + nrm(ks[7], (DEPTH, D_MODEL), 0.02),
        "w_in": nrm(ks[8], (DEPTH, D_MODEL, D_IN), D_MODEL ** -0.5),
        "pool_w": nrm(ks[9], (DEPTH, N_POOL_GROUPS, POOL_GROUP, POOL_GROUP), POOL_GROUP ** -0.5),
        "pool_scale": 1.0 + nrm(ks[10], (DEPTH, D_POOL), 0.02),
        "ret_decay_fwd": base_decay[None, :] + nrm(ks[11], (DEPTH, N_RET_HEADS), 0.1),
        "ret_decay_bwd": base_decay[None, :] + nrm(ks[12], (DEPTH, N_RET_HEADS), 0.1),
        "w_out": nrm(ks[13], (DEPTH, D_MIX, D_MODEL), D_MIX ** -0.5),
    }


def reference(x_prompt, x_sample, c_prompt, c_sample, ada_w, ada_b, norm_pre, norm_post,
              w_in, pool_w, pool_scale, ret_decay_fwd, ret_decay_bwd, w_out):
    y_prompt = x_prompt
    y_sample = x_sample
    for l in range(DEPTH):
        params = (ada_w[l], ada_b[l], norm_pre[l], norm_post[l], w_in[l], pool_w[l],
                  pool_scale[l], ret_decay_fwd[l], ret_decay_bwd[l], w_out[l])
        y_prompt = encoder_layer(y_prompt, c_prompt, *params)
        y_sample = encoder_layer(y_sample, c_sample, *params)
    return (y_prompt, y_sample)
```

```cpp
#include <hip/hip_runtime.h>
#include <hip/hip_cooperative_groups.h>
#include <cstdio>
#include <cstdint>
namespace cg = cooperative_groups;

#define LAS __attribute__((address_space(3)))
typedef unsigned short bf16_t;
typedef short bf16x8 __attribute__((ext_vector_type(8)));
typedef float f32x4 __attribute__((ext_vector_type(4)));
typedef unsigned u32x4 __attribute__((ext_vector_type(4)));
typedef unsigned u32x2 __attribute__((ext_vector_type(2)));

constexpr int NTHR = 512, NWAVES = 8;
constexpr int DM = 1024, DIN = 6144, DMIX = 2048;
constexpr int T_P = 65536, T_S = 32768, T_ALL = 98304, S_P = 8192, S_S = 4096;
constexpr float EPS = 1e-6f;
constexpr size_t MiB = 1u << 20;
constexpr size_t WS_MOD = 0;
constexpr size_t WS_WIN = 1 * MiB;
constexpr size_t WS_WOUT = 13 * MiB;
constexpr size_t WS_PART = 17 * MiB;
constexpr size_t WS_H = 24 * MiB;
constexpr size_t WS_U = 216 * MiB;
constexpr size_t WS_Q = 408 * MiB;
constexpr size_t WS_K = 600 * MiB;
constexpr size_t WS_VT = 792 * MiB;
constexpr size_t WS_END = 984 * MiB;
constexpr int LDS_BYTES = 147456;

__device__ __forceinline__ unsigned pk_bf16(float lo, float hi) { unsigned r; asm("v_cvt_pk_bf16_f32 %0, %1, %2" : "=v"(r) : "v"(lo), "v"(hi)); return r; }
__device__ __forceinline__ float bf_lo(unsigned u) { return __uint_as_float(u << 16); }
__device__ __forceinline__ float bf_hi(unsigned u) { return __uint_as_float(u & 0xffff0000u); }
__device__ __forceinline__ float wave_sum(float v) {
#pragma unroll
    for (int o = 1; o < 64; o <<= 1) v += __shfl_xor(v, o);
    return v;
}
__device__ __forceinline__ float silu_f(float z) { return z * __builtin_amdgcn_rcpf(1.0f + __builtin_amdgcn_exp2f(-1.4426950408889634f * z)); }
__device__ __forceinline__ void row_info(int m, int& b16, int& pos) { if (m < T_P) { b16 = m >> 13; pos = m & 8191; } else { const int mm = m - T_P; b16 = 8 + (mm >> 12); pos = mm & 4095; } }

namespace pg8 {
constexpr int BM = 256, BK = 64, HALF = 128, HTB = HALF * BK * 2, STAGE_BYTES = 8 * HTB, NXCD = 8, WGM = 8;
__host__ __device__ __forceinline__ int lds_byte(int r, int c) { const int st = (r >> 4) * 2 + (c >> 5), rr = r & 15, cc = c & 31, ob = rr * 64 + cc * 2; return st * 1024 + (ob ^ (((ob >> 9) & 1) << 5)); }
__host__ __device__ __forceinline__ void stage_rc(int b, int& R, int& C) { const int st = b / 1024, sb = b % 1024, swz = sb ^ (((sb >> 9) & 1) << 5); R = (st >> 1) * 16 + swz / 64; C = (st & 1) * 32 + (swz % 64) / 2; }
__host__ __device__ __forceinline__ int perm32(int rho) { const int n = rho >> 4, i = rho & 15; return 8 * (i >> 2) + 4 * n + (i & 3); }

struct Unit { const char* a; const char* b; int pm, pn; };

__device__ __forceinline__ bool order_next(int i, int G, int c, int nM, int nN, int& pm, int& pn) {
    const int nwg = nM * nN; const long L = (long)i * G + c; if (L >= nwg) return false;
    int wgid = (int)L; { const int q = nwg / NXCD, r = nwg % NXCD, xcd = wgid % NXCD, off = wgid / NXCD; wgid = (xcd < r ? xcd * (q + 1) : r * (q + 1) + (xcd - r) * q) + off; }
    const int nig = WGM * nN, gid = wgid / nig, fm = gid * WGM, gsz = (nM - fm) < WGM ? (nM - fm) : WGM;
    pm = fm + ((wgid % nig) % gsz); pn = (wgid % nig) / gsz; return true;
}

template <class Epi, class Sched>
__device__ __forceinline__ void gemm_phase(LAS unsigned char* lds, const int K, const Sched& S, const Epi& E) {
    const int tid = threadIdx.x, wid = __builtin_amdgcn_readfirstlane(tid >> 6), lane = tid & 63, wr = wid >> 2, wc = wid & 3, fr = lane & 15, fq = lane >> 4;
    const int nt = K / BK;
    unsigned voffA[2], voffB[2];
#pragma unroll
    for (int i = 0; i < 2; ++i) { int R, C; stage_rc(tid * 16 + i * 8192, R, C); const int Rb = (R & ~31) + perm32(R & 31);
        voffA[i] = (unsigned)(R * K + C) * 2u; voffB[i] = (unsigned)(Rb * K + C) * 2u; }
    const size_t kstep = (size_t)(BK * 2);
    const size_t hstep = (size_t)HALF * K * 2;
    const unsigned ldsw = (unsigned)wid * 1024u;
    const int aoff = lds_byte(wr * 64 + fr, fq * 8), boff = lds_byte(wc * 32 + fr, fq * 8);
#define PG8_SA(b, h) (((b) * 2 + (h)) * HTB)
#define PG8_SB(b, h) ((4 + (b) * 2 + (h)) * HTB)
#define PG8_STAGE(bufoff, gbase, voff) do { _Pragma("unroll") for (int _i = 0; _i < 2; ++_i) \
        __builtin_amdgcn_global_load_lds((const unsigned*)((const char*)(gbase) + (voff)[_i]), (LAS unsigned*)(lds + (bufoff) + ldsw + _i * 8192), 16, 0, 0); } while (0)
#define PG8_LDA(dst, b, h) do { _Pragma("unroll") for (int m = 0; m < 4; ++m) _Pragma("unroll") for (int k = 0; k < 2; ++k) dst[m][k] = *(const LAS bf16x8*)(lds + PG8_SA(b, h) + aoff + m * 2048 + k * 1024); } while (0)
#define PG8_LDB(dst, b, h) do { _Pragma("unroll") for (int n = 0; n < 2; ++n) _Pragma("unroll") for (int k = 0; k < 2; ++k) dst[n][k] = *(const LAS bf16x8*)(lds + PG8_SB(b, h) + boff + n * 2048 + k * 1024); } while (0)
#define PG8_MMA(ai, bj, At, Bt) do { __builtin_amdgcn_s_setprio(1); _Pragma("unroll") for (int m = 0; m < 4; ++m) _Pragma("unroll") for (int n = 0; n < 2; ++n) _Pragma("unroll") for (int k = 0; k < 2; ++k) \
        acc[ai][bj][m][n] = __builtin_amdgcn_mfma_f32_16x16x32_bf16(Bt[n][k], At[m][k], acc[ai][bj][m][n], 0, 0, 0); __builtin_amdgcn_s_setprio(0); } while (0)
#define PG8_WAIT_V(n) asm volatile("s_waitcnt vmcnt(" #n ")" ::: "memory")
#define PG8_WAIT_L(n) asm volatile("s_waitcnt lgkmcnt(" #n ")" ::: "memory")
#define PG8_BAR __builtin_amdgcn_s_barrier()
#define PG8_SCHED __builtin_amdgcn_sched_barrier(0)
    Unit cur, nxt; int ui = 0;
    if (!S.next(0, cur)) return;
    f32x4 acc[2][2][4][2];
#pragma unroll
    for (int a = 0; a < 2; ++a)
#pragma unroll
        for (int b = 0; b < 2; ++b)
#pragma unroll
            for (int m = 0; m < 4; ++m)
#pragma unroll
                for (int n = 0; n < 2; ++n) acc[a][b][m][n] = (f32x4){0.f, 0.f, 0.f, 0.f};
    bf16x8 At[4][2], B0[2][2], B1[2][2];
    const char* cA = cur.a; const char* cB = cur.b;
    PG8_STAGE(PG8_SB(0, 0), cB, voffB); PG8_STAGE(PG8_SB(0, 1), cB + hstep, voffB); PG8_STAGE(PG8_SA(0, 0), cA, voffA); PG8_STAGE(PG8_SA(0, 1), cA + hstep, voffA);
    if (wr == 1) PG8_BAR;
    PG8_WAIT_V(2); PG8_BAR;
    PG8_STAGE(PG8_SB(1, 0), cB + kstep, voffB); PG8_STAGE(PG8_SA(1, 0), cA + kstep, voffA); PG8_STAGE(PG8_SB(1, 1), cB + hstep + kstep, voffB);
    PG8_WAIT_V(6); PG8_BAR;
    for (;;) {
        const bool has_next = S.next(ui + 1, nxt);
        const char* nA = has_next ? nxt.a : cA; const char* nB = has_next ? nxt.b : cB;
        for (int t = 0; t < nt; t += 2) {
            const bool last = (t == nt - 2);
            const char* a1 = cA + (size_t)(t + 1) * kstep;
            const char* a2 = last ? nA : cA + (size_t)(t + 2) * kstep; const char* b2 = last ? nB : cB + (size_t)(t + 2) * kstep;
            const char* a3 = a2 + kstep; const char* b3 = b2 + kstep;
            PG8_LDB(B0, 0, 0); PG8_LDB(B1, 0, 1); PG8_SCHED; PG8_LDA(At, 0, 0); PG8_STAGE(PG8_SA(1, 1), a1 + hstep, voffA);
            PG8_WAIT_V(8); PG8_WAIT_L(0); PG8_BAR; PG8_MMA(0, 0, At, B0); PG8_MMA(0, 1, At, B1); PG8_BAR; PG8_SCHED;
            PG8_LDA(At, 0, 1); PG8_STAGE(PG8_SB(0, 0), b2, voffB); PG8_STAGE(PG8_SB(0, 1), b2 + hstep, voffB); PG8_STAGE(PG8_SA(0, 0), a2, voffA);
            PG8_WAIT_V(8); PG8_WAIT_L(0); PG8_BAR; PG8_MMA(1, 0, At, B0); PG8_MMA(1, 1, At, B1); PG8_BAR; PG8_SCHED;
            PG8_LDB(B0, 1, 0); PG8_LDB(B1, 1, 1); PG8_SCHED; PG8_LDA(At, 1, 0); PG8_STAGE(PG8_SA(0, 1), a2 + hstep, voffA);
            PG8_WAIT_V(8); PG8_WAIT_L(0); PG8_BAR; PG8_MMA(0, 0, At, B0); PG8_MMA(0, 1, At, B1); PG8_BAR; PG8_SCHED;
            PG8_LDA(At, 1, 1); PG8_STAGE(PG8_SB(1, 0), b3, voffB); PG8_STAGE(PG8_SB(1, 1), b3 + hstep, voffB); PG8_STAGE(PG8_SA(1, 0), a3, voffA);
            PG8_WAIT_V(8); PG8_WAIT_L(0); PG8_BAR; PG8_MMA(1, 0, At, B0); PG8_MMA(1, 1, At, B1); PG8_BAR; PG8_SCHED;
        }
        if (wr == 0) PG8_BAR;
        E(acc, cur, wr, wc, fr, fq);
        if (!has_next) break;
#pragma unroll
        for (int a = 0; a < 2; ++a)
#pragma unroll
            for (int b = 0; b < 2; ++b)
#pragma unroll
                for (int m = 0; m < 4; ++m)
#pragma unroll
                    for (int n = 0; n < 2; ++n) acc[a][b][m][n] = (f32x4){0.f, 0.f, 0.f, 0.f};
        cur = nxt; cA = nA; cB = nB; ++ui;
        if (wr == 1) PG8_BAR;
    }
    PG8_WAIT_V(0);
    PG8_BAR;
#undef PG8_SA
#undef PG8_SB
#undef PG8_STAGE
#undef PG8_LDA
#undef PG8_LDB
#undef PG8_MMA
#undef PG8_WAIT_V
#undef PG8_WAIT_L
#undef PG8_BAR
#undef PG8_SCHED
}
}

struct Args { const float* in[14]; float* out; unsigned char* ws; int ph_lo, ph_hi; };

struct Ctx {
    const float *xp, *xs, *cp, *cs, *ada_w, *ada_b, *g_pre, *g_post, *w_in, *pool_w, *pool_scale, *dec_f, *dec_b, *w_out;
    float* out; unsigned char* ws;
    float* mod; bf16_t *WinT, *WoutT; float* part; bf16_t *H, *U, *Q, *Kb, *VT, *Z, *KV, *OUTB;
    int tid, lane, wave, G, bid;
};
__device__ __forceinline__ const float* x_row(const Ctx& F, int m) { return m < T_P ? F.xp + (size_t)m * DM : F.xs + (size_t)(m - T_P) * DM; }

__device__ __forceinline__ int colmap(int rho) {
    const int pn = rho >> 8;
    if (pn < 4 || pn >= 12) return rho;
    const int s = rho & 255, bj = s >> 7, sp = s & 127;
    return 1024 * (pn >> 2) + (2 * (pn & 3) + (sp >> 6)) * 128 + 64 * bj + (sp & 63);
}
__device__ __forceinline__ void p0_write_tile(bf16_t* WT, int Kdst, int row0, int k0, LAS float* scr, int lane) {
    asm volatile("s_waitcnt lgkmcnt(0)" ::: "memory");
    const int c = lane & 7;
#pragma unroll
    for (int j = 0; j < 4; ++j) { const int n = (lane >> 3) + 8 * j; const LAS float* s = scr + (8 * c) * 33 + n;
        u32x4 o; o.x = pk_bf16(s[0 * 33], s[1 * 33]); o.y = pk_bf16(s[2 * 33], s[3 * 33]); o.z = pk_bf16(s[4 * 33], s[5 * 33]); o.w = pk_bf16(s[6 * 33], s[7 * 33]);
        *(u32x4*)(WT + (size_t)(row0 + n) * Kdst + k0 + 8 * c) = o; }
    asm volatile("s_waitcnt lgkmcnt(0)" ::: "memory");
}
__device__ __forceinline__ void p0_transpose_item(const float* W, int N, int k0, int n0src, bf16_t* WT, int Kdst, int row0, LAS float* scr, int lane) {
#pragma unroll 8
    for (int i = 0; i < 32; ++i) { const int kk = 2 * i + (lane >> 5); scr[kk * 33 + (lane & 31)] = W[(size_t)(k0 + kk) * N + n0src + (lane & 31)]; }
    p0_write_tile(WT, Kdst, row0, k0, scr, lane);
}
__device__ __forceinline__ void p0_fold_item(const Ctx& F, int item, LAS float* scr, int lane) {
    const int kb = item >> 5, nb = item & 31, k0 = 64 * kb, rho0 = 32 * nb, g = rho0 >> 8, d0 = rho0 & 255;
    const int kl = lane >> 3, dg = lane & 7;
    f32x4 acc[8];
#pragma unroll
    for (int q = 0; q < 8; ++q) acc[q] = (f32x4){0.f, 0.f, 0.f, 0.f};
    const float* pw0 = F.pool_w + (size_t)g * 65536 + d0 + 4 * dg;
    const float* wi0 = F.w_in + (size_t)(k0 + kl) * DIN + g * 256;
    for (int c = 0; c < 256; c += 4) {
        f32x4 pw[4];
#pragma unroll
        for (int cc = 0; cc < 4; ++cc) pw[cc] = *(const f32x4*)(pw0 + (size_t)(c + cc) * 256);
#pragma unroll
        for (int q = 0; q < 8; ++q) { const f32x4 wv = *(const f32x4*)(wi0 + (size_t)(8 * q) * DIN + c);
            acc[q] += wv.x * pw[0] + wv.y * pw[1] + wv.z * pw[2] + wv.w * pw[3]; }
    }
#pragma unroll
    for (int q = 0; q < 8; ++q)
#pragma unroll
        for (int e = 0; e < 4; ++e) scr[(kl + 8 * q) * 33 + 4 * dg + e] = acc[q][e];
    p0_write_tile(F.WinT, DM, rho0, k0, scr, lane);
}
__device__ __forceinline__ void p0_prologue(const Ctx& F, LAS unsigned char* lds) {
    LAS float* scr = (LAS float*)(lds + F.wave * 16384);
    if (F.bid < 48) {
        LAS float* sv = scr; LAS float* red = (LAS float*)(lds + F.wave * 16384 + 12288);
        const int kw0 = 128 * F.wave;
        for (int idx = F.lane; idx < 2048; idx += 64) { const int r = idx >> 7, kk = idx & 127;
            const float c = r < 8 ? F.cp[r * DM + kw0 + kk] : F.cs[(r - 8) * DM + kw0 + kk]; sv[idx] = silu_f(c); }
        asm volatile("s_waitcnt lgkmcnt(0)" ::: "memory");
        float a16[16];
#pragma unroll
        for (int r = 0; r < 16; ++r) a16[r] = 0.f;
        const float* wp = F.ada_w + (size_t)kw0 * 3072 + 64 * F.bid + F.lane;
        for (int kk = 0; kk < 128; ++kk) { const float wv = wp[(size_t)kk * 3072];
#pragma unroll
            for (int r = 0; r < 16; ++r) a16[r] += sv[r * 128 + kk] * wv; }
#pragma unroll
        for (int r = 0; r < 16; ++r) red[r * 64 + F.lane] = a16[r];
        __syncthreads();
        for (int o = F.tid; o < 1024; o += NTHR) { const int r = o >> 6, col = o & 63; float s = F.ada_b[64 * F.bid + col];
#pragma unroll
            for (int w = 0; w < 8; ++w) s += *((LAS float*)(lds + w * 16384 + 12288) + r * 64 + col);
            F.mod[r * 3072 + 64 * F.bid + col] = s; }
    }
    const int gw = F.bid * NWAVES + F.wave, NGW = F.G * NWAVES;
    constexpr int I_FOLD = 512, I_IN = 16 * 160, I_OUT = 32 * 32;
    for (int it = gw; it < I_FOLD + I_IN + I_OUT; it += NGW) {
        int r = it;
        if (r < I_FOLD) { p0_fold_item(F, r, scr, F.lane); continue; } r -= I_FOLD;
        if (r < I_IN) { const int kb = r / 160, nb = r % 160, rho0 = 1024 + 32 * nb; p0_transpose_item(F.w_in, DIN, 64 * kb, colmap(rho0), F.WinT, DM, rho0, scr, F.lane); continue; } r -= I_IN;
        { const int kb = r >> 5, nb = r & 31; p0_transpose_item(F.w_out, DM, 64 * kb, 32 * nb, F.WoutT, DMIX, 32 * nb, scr, F.lane); }
    }
}

__device__ __forceinline__ void p1_prenorm(const Ctx& F) {
    const int gw = F.bid * NWAVES + F.wave, NGW = F.G * NWAVES;
    for (int gi = gw; gi < T_ALL / 16; gi += NGW) {
        const int m0 = gi * 16; int b16, pos; row_info(m0, b16, pos);
        const float* md = F.mod + b16 * 3072;
        f32x4 ga[4], sh[4];
#pragma unroll
        for (int j = 0; j < 4; ++j) { const int c = 4 * F.lane + 256 * j; const f32x4 g = *(const f32x4*)(F.g_pre + c), sc = *(const f32x4*)(md + 1024 + c);
            ga[j] = g * (sc + 1.0f); sh[j] = *(const f32x4*)(md + c); }
        for (int r = 0; r < 16; ++r) {
            const f32x4* xr = (const f32x4*)x_row(F, m0 + r) + F.lane;
            f32x4 v[4]; float s = 0.f;
#pragma unroll
            for (int j = 0; j < 4; ++j) { v[j] = xr[64 * j]; s += (v[j].x * v[j].x + v[j].y * v[j].y) + (v[j].z * v[j].z + v[j].w * v[j].w); }
            const float rstd = rsqrtf(wave_sum(s) * (1.f / DM) + EPS);
            u32x2* o8 = (u32x2*)(F.H + (size_t)(m0 + r) * DM) + F.lane;
#pragma unroll
            for (int j = 0; j < 4; ++j) { const f32x4 y = v[j] * rstd * ga[j] + sh[j]; u32x2 w; w.x = pk_bf16(y.x, y.y); w.y = pk_bf16(y.z, y.w); o8[64 * j] = w; }
        }
    }
}

struct SchedIn {
    const char* H; const char* W; int G, c;
    __device__ __forceinline__ bool next(int i, pg8::Unit& u) const {
        int pm, pn; if (!pg8::order_next(i, G, c, T_ALL / 256, DIN / 256, pm, pn)) return false;
        const size_t tstep = (size_t)256 * DM * 2; const char* hp = H + (size_t)pm * tstep; const char* wp = W + (size_t)pn * tstep;
        const bool sw = (pn >= 12 && pn < 16);
        u.a = sw ? wp : hp; u.b = sw ? hp : wp; u.pm = pm; u.pn = pn; return true;
    }
};
struct EpiIn {
    bf16_t *U, *Q, *Kb, *VT, *Z;
    __device__ __forceinline__ void operator()(const f32x4 (&acc)[2][2][4][2], const pg8::Unit& u, int wr, int wc, int fr, int fq) const {
        const int pm = u.pm, pn = u.pn;
        if (pn < 4) {
#pragma unroll
            for (int ai = 0; ai < 2; ++ai)
#pragma unroll
                for (int m = 0; m < 4; ++m) { bf16_t* rp = U + (size_t)(pm * 256 + ai * 128 + wr * 64 + m * 16 + fr) * DM + pn * 256 + wc * 32 + 8 * fq;
#pragma unroll
                    for (int bj = 0; bj < 2; ++bj) { const f32x4 v0 = acc[ai][bj][m][0], v1 = acc[ai][bj][m][1];
                        u32x4 w; w.x = pk_bf16(v0[0], v0[1]); w.y = pk_bf16(v0[2], v0[3]); w.z = pk_bf16(v1[0], v1[1]); w.w = pk_bf16(v1[2], v1[3]);
                        *(u32x4*)(rp + bj * 128) = w; } }
        } else if (pn < 12) {
            const bool isk = pn >= 8; bf16_t* base = isk ? Kb : Q; const float scl = isk ? 0.08838834764831845f : 1.0f;
            const int head = 2 * (pn & 3) + (wc >> 1), dlo = 32 * (wc & 1) + 8 * fq;
            const int pos0 = pm < 256 ? (pm & 31) * 256 : ((pm - 256) & 15) * 256;
            float cf[8];
#pragma unroll
            for (int e = 0; e < 8; ++e) cf[e] = __builtin_amdgcn_exp2f(-(float)(dlo + e) * 0.20762050593046014f) * 0.15915494309189535f;
#pragma unroll
            for (int ai = 0; ai < 2; ++ai)
#pragma unroll
                for (int m = 0; m < 4; ++m) {
                    const int rl = ai * 128 + wr * 64 + m * 16 + fr; const float fpos = (float)(pos0 + rl);
                    float o1[8], o2[8];
#pragma unroll
                    for (int e = 0; e < 8; ++e) {
                        const float rev = fpos * cf[e]; const float fr_ = __builtin_amdgcn_fractf(rev);
                        const float sn = __builtin_amdgcn_sinf(fr_), cs = __builtin_amdgcn_cosf(fr_);
                        const float x1 = acc[ai][0][m][e >> 2][e & 3], x2 = acc[ai][1][m][e >> 2][e & 3];
                        o1[e] = (x1 * cs - x2 * sn) * scl; o2[e] = (x2 * cs + x1 * sn) * scl;
                    }
                    bf16_t* rp = base + (size_t)(pm * 256 + rl) * DM + head * 128 + dlo;
                    u32x4 w1, w2; w1.x = pk_bf16(o1[0], o1[1]); w1.y = pk_bf16(o1[2], o1[3]); w1.z = pk_bf16(o1[4], o1[5]); w1.w = pk_bf16(o1[6], o1[7]);
                    w2.x = pk_bf16(o2[0], o2[1]); w2.y = pk_bf16(o2[2], o2[3]); w2.z = pk_bf16(o2[4], o2[5]); w2.w = pk_bf16(o2[6], o2[7]);
                    *(u32x4*)rp = w1; *(u32x4*)(rp + 64) = w2;
                }
        } else if (pn < 16) {
            int b, t0, S; size_t gbase;
            if (pm < 256) { b = pm >> 5; t0 = (pm & 31) * 256; S = S_P; gbase = 0; } else { const int q = pm - 256; b = q >> 4; t0 = (q & 15) * 256; S = S_S; gbase = (size_t)64 * 128 * S_P; }
#pragma unroll
            for (int ai = 0; ai < 2; ++ai)
#pragma unroll
                for (int m = 0; m < 4; ++m) { const int head = 2 * (pn - 12) + ai, dv = wr * 64 + m * 16 + fr;
                    bf16_t* rp = VT + gbase + ((size_t)(b * 8 + head) * 128 + dv) * S + t0 + wc * 32 + 8 * fq;
#pragma unroll
                    for (int bj = 0; bj < 2; ++bj) { const f32x4 v0 = acc[ai][bj][m][0], v1 = acc[ai][bj][m][1];
                        u32x4 w; w.x = pk_bf16(v0[0], v0[1]); w.y = pk_bf16(v0[2], v0[3]); w.z = pk_bf16(v1[0], v1[1]); w.w = pk_bf16(v1[2], v1[3]);
                        *(u32x4*)(rp + bj * 128) = w; } }
        } else {
#pragma unroll
            for (int ai = 0; ai < 2; ++ai)
#pragma unroll
                for (int m = 0; m < 4; ++m) { bf16_t* rp = Z + (size_t)(pm * 256 + ai * 128 + wr * 64 + m * 16 + fr) * DMIX + (pn - 16) * 256 + wc * 32 + 8 * fq;
#pragma unroll
                    for (int bj = 0; bj < 2; ++bj) { const f32x4 v0 = acc[ai][bj][m][0], v1 = acc[ai][bj][m][1];
                        u32x4 w; w.x = pk_bf16(silu_f(v0[0]), silu_f(v0[1])); w.y = pk_bf16(silu_f(v0[2]), silu_f(v0[3])); w.z = pk_bf16(silu_f(v1[0]), silu_f(v1[1])); w.w = pk_bf16(silu_f(v1[2]), silu_f(v1[3]));
                        *(u32x4*)(rp + bj * 128) = w; } }
        }
    }
};

struct RItem { int S, m0, h, nsc, sc; const bf16_t* vt; };
__device__ __forceinline__ RItem ritem(const Ctx& F, int it) {
    RItem r;
    if (it < 2048) { const int bh = it >> 5; r.sc = it & 31; r.S = S_P; r.nsc = 32; r.h = bh & 7; r.m0 = (bh >> 3) * S_P + r.sc * 256; r.vt = F.VT + (size_t)bh * 128 * S_P + r.sc * 256; }
    else { const int q = it - 2048, bh = q >> 4; r.sc = q & 15; r.S = S_S; r.nsc = 16; r.h = bh & 7; r.m0 = T_P + (bh >> 3) * S_S + r.sc * 256; r.vt = F.VT + (size_t)64 * 128 * S_P + (size_t)bh * 128 * S_S + r.sc * 256; }
    return r;
}
__device__ __forceinline__ float log2_gamma(const float* dec, int h) { return log1pf(-exp2f(-dec[h])) * 1.4426950408889634f; }

__device__ __forceinline__ void ra_item(const Ctx& F, int it, LAS unsigned char* lds) {
    const RItem R = ritem(F, it);
    const int tid = F.tid, w = F.wave, lane = F.lane, l15 = lane & 15, g = lane >> 4;
    LAS unsigned char* Kl = lds;
    LAS unsigned char* Vl = lds + 69632;
#pragma unroll
    for (int p = 0; p < 8; ++p) { const int idx = p * NTHR + tid, row = idx >> 4, c = idx & 15;
        const u32x4 v = *(const u32x4*)(F.Kb + (size_t)(R.m0 + row) * DM + R.h * 128 + c * 8);
        LAS u32x2* d = (LAS u32x2*)(Kl + row * 264 + c * 16); d[0] = (u32x2){v.x, v.y}; d[1] = (u32x2){v.z, v.w}; }
#pragma unroll
    for (int p = 0; p < 8; ++p) { const int idx = p * NTHR + tid, row = idx >> 5, c = idx & 31;
        const u32x4 v = *(const u32x4*)(R.vt + (size_t)row * R.S + c * 8);
        *(LAS u32x4*)(Vl + row * 528 + c * 16) = v; }
    __syncthreads();
    const int dir = w >> 2, dk0 = (w & 3) * 32;
    const float lg2 = log2_gamma(dir ? F.dec_b : F.dec_f, R.h);
    f32x4 acc[2][8];
#pragma unroll
    for (int mt = 0; mt < 2; ++mt)
#pragma unroll
        for (int nt = 0; nt < 8; ++nt) acc[mt][nt] = (f32x4){0.f, 0.f, 0.f, 0.f};
    const LAS bf16_t* Ks = (const LAS bf16_t*)Kl;
#pragma unroll 2
    for (int kk = 0; kk < 8; ++kk) {
        float wj[8];
#pragma unroll
        for (int e = 0; e < 8; ++e) { const int j = 32 * kk + 8 * g + e; wj[e] = __builtin_amdgcn_exp2f(lg2 * (float)(dir ? j : 255 - j)); }
        bf16x8 af[2];
#pragma unroll
        for (int mt = 0; mt < 2; ++mt) { const int dk = dk0 + 16 * mt + l15; float t[8];
#pragma unroll
            for (int e = 0; e < 8; ++e) t[e] = __uint_as_float((unsigned)Ks[(32 * kk + 8 * g + e) * 132 + dk] << 16) * wj[e];
            u32x4 pa; pa.x = pk_bf16(t[0], t[1]); pa.y = pk_bf16(t[2], t[3]); pa.z = pk_bf16(t[4], t[5]); pa.w = pk_bf16(t[6], t[7]);
            af[mt] = __builtin_bit_cast(bf16x8, pa); }
#pragma unroll
        for (int nt = 0; nt < 8; ++nt) { const bf16x8 bfr = *(const LAS bf16x8*)(Vl + (16 * nt + l15) * 528 + (32 * kk + 8 * g) * 2);
#pragma unroll
            for (int mt = 0; mt < 2; ++mt) acc[mt][nt] = __builtin_amdgcn_mfma_f32_16x16x32_bf16(af[mt], bfr, acc[mt][nt], 0, 0, 0); }
    }
    bf16_t* kv = F.KV + (size_t)it * 32768 + dir * 16384;
#pragma unroll
    for (int mt = 0; mt < 2; ++mt)
#pragma unroll
        for (int nt = 0; nt < 8; ++nt) { const f32x4 v = acc[mt][nt]; u32x2 o; o.x = pk_bf16(v[0], v[1]); o.y = pk_bf16(v[2], v[3]);
            *(u32x2*)(kv + (16 * nt + l15) * 128 + dk0 + 16 * mt + 4 * g) = o; }
    __syncthreads();
}

__device__ __forceinline__ void pool_item(const Ctx& F, int pt) {
    const int cg8 = F.tid & 127, tq = F.tid >> 7, ch = 8 * cg8, half = 1 << (cg8 >> 5);
    const int m0 = pt * 64 + tq * 16; int b16, pos0; row_info(m0, b16, pos0);
    const int S = m0 < T_P ? S_P : S_S; const int mseq = m0 - pos0;
    const bf16_t* ub = F.U + (size_t)mseq * DM + ch;
    float ps[8];
    { const f32x4 a = *(const f32x4*)(F.pool_scale + ch), b = *(const f32x4*)(F.pool_scale + ch + 4); ps[0] = a.x; ps[1] = a.y; ps[2] = a.z; ps[3] = a.w; ps[4] = b.x; ps[5] = b.y; ps[6] = b.z; ps[7] = b.w; }
    float sum[8];
#pragma unroll
    for (int e = 0; e < 8; ++e) sum[e] = 0.f;
    { const int lo = max(pos0 - half, 0), hi = min(pos0 + half, S);
      for (int s = lo; s < hi; ++s) { const u32x4 v = *(const u32x4*)(ub + (size_t)s * DM);
          sum[0] += bf_lo(v.x); sum[1] += bf_hi(v.x); sum[2] += bf_lo(v.y); sum[3] += bf_hi(v.y); sum[4] += bf_lo(v.z); sum[5] += bf_hi(v.z); sum[6] += bf_lo(v.w); sum[7] += bf_hi(v.w); } }
    for (int r = 0; r < 16; ++r) {
        const int pos = pos0 + r;
        if (r > 0) {
            const int add = pos + half - 1, rem = pos - 1 - half;
            if (add < S) { const u32x4 v = *(const u32x4*)(ub + (size_t)add * DM);
                sum[0] += bf_lo(v.x); sum[1] += bf_hi(v.x); sum[2] += bf_lo(v.y); sum[3] += bf_hi(v.y); sum[4] += bf_lo(v.z); sum[5] += bf_hi(v.z); sum[6] += bf_lo(v.w); sum[7] += bf_hi(v.w); }
            if (rem >= 0) { const u32x4 v = *(const u32x4*)(ub + (size_t)rem * DM);
                sum[0] -= bf_lo(v.x); sum[1] -= bf_hi(v.x); sum[2] -= bf_lo(v.y); sum[3] -= bf_hi(v.y); sum[4] -= bf_lo(v.z); sum[5] -= bf_hi(v.z); sum[6] -= bf_lo(v.w); sum[7] -= bf_hi(v.w); }
        }
        const int lo = max(pos - half, 0), hi = min(pos + half, S); const float inv = 1.0f / (float)(hi - lo);
        const u32x4 c = *(const u32x4*)(ub + (size_t)pos * DM);
        bf16_t* zp = F.Z + (size_t)(mseq + pos) * DMIX + ch;
        const u32x4 z = *(const u32x4*)zp;
        float y[8];
        y[0] = (sum[0] * inv - bf_lo(c.x)) * ps[0] * bf_lo(z.x); y[1] = (sum[1] * inv - bf_hi(c.x)) * ps[1] * bf_hi(z.x);
        y[2] = (sum[2] * inv - bf_lo(c.y)) * ps[2] * bf_lo(z.y); y[3] = (sum[3] * inv - bf_hi(c.y)) * ps[3] * bf_hi(z.y);
        y[4] = (sum[4] * inv - bf_lo(c.z)) * ps[4] * bf_lo(z.z); y[5] = (sum[5] * inv - bf_hi(c.z)) * ps[5] * bf_hi(z.z);
        y[6] = (sum[6] * inv - bf_lo(c.w)) * ps[6] * bf_lo(z.w); y[7] = (sum[7] * inv - bf_hi(c.w)) * ps[7] * bf_hi(z.w);
        u32x4 o; o.x = pk_bf16(y[0], y[1]); o.y = pk_bf16(y[2], y[3]); o.z = pk_bf16(y[4], y[5]); o.w = pk_bf16(y[6], y[7]);
        *(u32x4*)zp = o;
    }
}

__device__ __forceinline__ void rb_scan(const Ctx& F) {
    for (int q = F.bid; q < 1024; q += F.G) {
        const int seq = q >> 3, dir = (q >> 2) & 1, quarter = q & 3;
        const int nsc = seq < 64 ? 32 : 16, it0 = seq < 64 ? seq * 32 : 2048 + (seq - 64) * 16, h = seq & 7;
        const float Gd = __builtin_amdgcn_exp2f(256.0f * log2_gamma(dir ? F.dec_b : F.dec_f, h));
        bf16_t* base = F.KV + (size_t)it0 * 32768 + dir * 16384 + quarter * 4096 + F.tid * 8;
        float st[8];
#pragma unroll
        for (int e = 0; e < 8; ++e) st[e] = 0.f;
        for (int s0 = 0; s0 < nsc; s0 += 4) {
            u32x4 v[4];
#pragma unroll
            for (int u = 0; u < 4; ++u) { const int sc = dir ? nsc - 1 - (s0 + u) : s0 + u; v[u] = *(const u32x4*)(base + (size_t)sc * 32768); }
#pragma unroll
            for (int u = 0; u < 4; ++u) { const int sc = dir ? nsc - 1 - (s0 + u) : s0 + u;
                u32x4 o; o.x = pk_bf16(st[0], st[1]); o.y = pk_bf16(st[2], st[3]); o.z = pk_bf16(st[4], st[5]); o.w = pk_bf16(st[6], st[7]);
                *(u32x4*)(base + (size_t)sc * 32768) = o;
                st[0] = st[0] * Gd + bf_lo(v[u].x); st[1] = st[1] * Gd + bf_hi(v[u].x); st[2] = st[2] * Gd + bf_lo(v[u].y); st[3] = st[3] * Gd + bf_hi(v[u].y);
                st[4] = st[4] * Gd + bf_lo(v[u].z); st[5] = st[5] * Gd + bf_hi(v[u].z); st[6] = st[6] * Gd + bf_lo(v[u].w); st[7] = st[7] * Gd + bf_hi(v[u].w); }
        }
    }
}

__device__ __forceinline__ void rc_item(const Ctx& F, int it, LAS unsigned char* lds) {
    const RItem R = ritem(F, it);
    const int tid = F.tid, w = F.wave, lane = F.lane, l15 = lane & 15, g = lane >> 4;
    LAS unsigned char* Kl = lds;
    LAS unsigned char* Vl = lds + 69632;
    LAS float* tab = (LAS float*)(lds + 137216);
    const float lg2f = log2_gamma(F.dec_f, R.h), lg2b = log2_gamma(F.dec_b, R.h);
#pragma unroll
    for (int p = 0; p < 8; ++p) { const int idx = p * NTHR + tid, row = idx >> 4, c = idx & 15;
        *(LAS u32x4*)(Kl + row * 272 + c * 16) = *(const u32x4*)(F.Kb + (size_t)(R.m0 + row) * DM + R.h * 128 + c * 8); }
#pragma unroll
    for (int p = 0; p < 8; ++p) { const int idx = p * NTHR + tid, row = idx >> 5, c = idx & 31;
        *(LAS u32x4*)(Vl + row * 528 + c * 16) = *(const u32x4*)(R.vt + (size_t)row * R.S + c * 8); }
    tab[tid] = tid < 256 ? __builtin_amdgcn_exp2f(-lg2f * (float)tid) : __builtin_amdgcn_exp2f(lg2b * (float)(tid - 256));
    bf16x8 qf[2][4];
#pragma unroll
    for (int n2 = 0; n2 < 2; ++n2)
#pragma unroll
        for (int kk = 0; kk < 4; ++kk) qf[n2][kk] = *(const bf16x8*)(F.Q + (size_t)(R.m0 + 32 * w + 16 * n2 + l15) * DM + R.h * 128 + 32 * kk + 8 * g);
    __syncthreads();
    bf16x8 pf[8][2];
    {
        float fa[2], ba[2]; int irow[2];
#pragma unroll
        for (int n2 = 0; n2 < 2; ++n2) { irow[n2] = 32 * w + 16 * n2 + l15; fa[n2] = __builtin_amdgcn_exp2f(lg2f * (float)irow[n2]); ba[n2] = __builtin_amdgcn_exp2f(-lg2b * (float)irow[n2]); }
#pragma unroll
        for (int k2 = 0; k2 < 8; ++k2) {
            f32x4 s[2][2];
#pragma unroll
            for (int jj = 0; jj < 2; ++jj)
#pragma unroll
                for (int n2 = 0; n2 < 2; ++n2) s[jj][n2] = (f32x4){0.f, 0.f, 0.f, 0.f};
#pragma unroll
            for (int jj = 0; jj < 2; ++jj)
#pragma unroll
                for (int kk = 0; kk < 4; ++kk) { const bf16x8 a = *(const LAS bf16x8*)(Kl + (16 * (2 * k2 + jj) + l15) * 272 + (32 * kk + 8 * g) * 2);
#pragma unroll
                    for (int n2 = 0; n2 < 2; ++n2) s[jj][n2] = __builtin_amdgcn_mfma_f32_16x16x32_bf16(a, qf[n2][kk], s[jj][n2], 0, 0, 0); }
            f32x4 tf[2], tb[2];
#pragma unroll
            for (int jj = 0; jj < 2; ++jj) { tf[jj] = *(const LAS f32x4*)(tab + 32 * k2 + 16 * jj + 4 * g); tb[jj] = *(const LAS f32x4*)(tab + 256 + 32 * k2 + 16 * jj + 4 * g); }
#pragma unroll
            for (int n2 = 0; n2 < 2; ++n2) { float p[8];
#pragma unroll
                for (int jj = 0; jj < 2; ++jj)
#pragma unroll
                    for (int r = 0; r < 4; ++r) { const int j = 32 * k2 + 16 * jj + 4 * g + r; const float d = (j <= irow[n2]) ? fa[n2] * tf[jj][r] : ba[n2] * tb[jj][r]; p[4 * jj + r] = s[jj][n2][r] * d; }
                u32x4 pp; pp.x = pk_bf16(p[0], p[1]); pp.y = pk_bf16(p[2], p[3]); pp.z = pk_bf16(p[4], p[5]); pp.w = pk_bf16(p[6], p[7]);
                pf[k2][n2] = __builtin_bit_cast(bf16x8, pp); }
        }
    }
    f32x4 o[8][2];
#pragma unroll
    for (int mt = 0; mt < 8; ++mt)
#pragma unroll
        for (int n2 = 0; n2 < 2; ++n2) o[mt][n2] = (f32x4){0.f, 0.f, 0.f, 0.f};
#pragma unroll
    for (int mt = 0; mt < 8; ++mt)
#pragma unroll
        for (int k2 = 0; k2 < 8; ++k2) { const LAS unsigned char* vp = Vl + (16 * mt + l15) * 528 + (32 * k2 + 4 * g) * 2;
            const u32x2 lo = *(const LAS u32x2*)vp, hi = *(const LAS u32x2*)(vp + 32);
            const bf16x8 a = __builtin_bit_cast(bf16x8, (u32x4){lo.x, lo.y, hi.x, hi.y});
#pragma unroll
            for (int n2 = 0; n2 < 2; ++n2) o[mt][n2] = __builtin_amdgcn_mfma_f32_16x16x32_bf16(a, pf[k2][n2], o[mt][n2], 0, 0, 0); }
    __syncthreads();
    { const bf16_t* kv = F.KV + (size_t)it * 32768;
#pragma unroll
      for (int p = 0; p < 8; ++p) { const int idx = p * NTHR + tid, row = idx >> 4, c = idx & 15;
          *(LAS u32x4*)(Kl + row * 272 + c * 16) = *(const u32x4*)(kv + (size_t)idx * 8); } }
    __syncthreads();
    {
        float qfd[2], qbd[2];
#pragma unroll
        for (int n2 = 0; n2 < 2; ++n2) { const int i = 32 * w + 16 * n2 + l15; qfd[n2] = __builtin_amdgcn_exp2f(lg2f * (float)(i + 1)); qbd[n2] = __builtin_amdgcn_exp2f(lg2b * (float)(256 - i)); }
#pragma unroll
        for (int mt = 0; mt < 8; ++mt) {
            f32x4 tf[2], tb[2];
#pragma unroll
            for (int n2 = 0; n2 < 2; ++n2) { tf[n2] = (f32x4){0.f, 0.f, 0.f, 0.f}; tb[n2] = (f32x4){0.f, 0.f, 0.f, 0.f}; }
#pragma unroll
            for (int kk = 0; kk < 4; ++kk) { const LAS unsigned char* sp = Kl + (16 * mt + l15) * 272 + (32 * kk + 8 * g) * 2;
                const bf16x8 af = *(const LAS bf16x8*)sp, ab = *(const LAS bf16x8*)(sp + 34816);
#pragma unroll
                for (int n2 = 0; n2 < 2; ++n2) { tf[n2] = __builtin_amdgcn_mfma_f32_16x16x32_bf16(af, qf[n2][kk], tf[n2], 0, 0, 0); tb[n2] = __builtin_amdgcn_mfma_f32_16x16x32_bf16(ab, qf[n2][kk], tb[n2], 0, 0, 0); } }
#pragma unroll
            for (int n2 = 0; n2 < 2; ++n2) o[mt][n2] += tf[n2] * qfd[n2] + tb[n2] * qbd[n2];
        }
    }
#pragma unroll
    for (int n2 = 0; n2 < 2; ++n2) {
        float s1 = 0.f;
#pragma unroll
        for (int mt = 0; mt < 8; ++mt) s1 += (o[mt][n2][0] + o[mt][n2][1]) + (o[mt][n2][2] + o[mt][n2][3]);
        s1 += __shfl_xor(s1, 16); s1 += __shfl_xor(s1, 32);
        const float mu = s1 * (1.0f / 128.0f); float s2 = 0.f;
#pragma unroll
        for (int mt = 0; mt < 8; ++mt) { const f32x4 d = o[mt][n2] - mu; s2 += (d[0] * d[0] + d[1] * d[1]) + (d[2] * d[2] + d[3] * d[3]); }
        s2 += __shfl_xor(s2, 16); s2 += __shfl_xor(s2, 32);
        const float rs = rsqrtf(s2 * (1.0f / 128.0f) + EPS);
        bf16_t* zp = F.Z + (size_t)(R.m0 + 32 * w + 16 * n2 + l15) * DMIX + 1024 + R.h * 128 + 4 * g;
#pragma unroll
        for (int mt = 0; mt < 8; ++mt) { const u32x2 z = *(const u32x2*)(zp + 16 * mt); const f32x4 d = (o[mt][n2] - mu) * rs;
            u32x2 ov; ov.x = pk_bf16(d[0] * bf_lo(z.x), d[1] * bf_hi(z.x)); ov.y = pk_bf16(d[2] * bf_lo(z.y), d[3] * bf_hi(z.y));
            *(u32x2*)(zp + 16 * mt) = ov; }
    }
    __syncthreads();
}

struct SchedOut {
    const char* Y; const char* W; int G, c;
    __device__ __forceinline__ bool next(int i, pg8::Unit& u) const {
        int pm, pn; if (!pg8::order_next(i, G, c, T_ALL / 256, DM / 256, pm, pn)) return false;
        const size_t tstep = (size_t)256 * DMIX * 2; u.a = Y + (size_t)pm * tstep; u.b = W + (size_t)pn * tstep; u.pm = pm; u.pn = pn; return true;
    }
};
struct EpiOut {
    bf16_t* O; float* part;
    __device__ __forceinline__ void operator()(const f32x4 (&acc)[2][2][4][2], const pg8::Unit& u, int wr, int wc, int fr, int fq) const {
#pragma unroll
        for (int ai = 0; ai < 2; ++ai)
#pragma unroll
            for (int m = 0; m < 4; ++m) { const size_t row = (size_t)(u.pm * 256 + ai * 128 + wr * 64 + m * 16 + fr); bf16_t* rp = O + row * DM + u.pn * 256 + wc * 32 + 8 * fq; float ss = 0.f;
#pragma unroll
                for (int bj = 0; bj < 2; ++bj) { const f32x4 v0 = acc[ai][bj][m][0], v1 = acc[ai][bj][m][1];
                    ss += (v0[0] * v0[0] + v0[1] * v0[1]) + (v0[2] * v0[2] + v0[3] * v0[3]) + (v1[0] * v1[0] + v1[1] * v1[1]) + (v1[2] * v1[2] + v1[3] * v1[3]);
                    u32x4 w; w.x = pk_bf16(v0[0], v0[1]); w.y = pk_bf16(v0[2], v0[3]); w.z = pk_bf16(v1[0], v1[1]); w.w = pk_bf16(v1[2], v1[3]);
                    *(u32x4*)(rp + bj * 128) = w; }
                ss += __shfl_xor(ss, 16); ss += __shfl_xor(ss, 32);
                if (fq == 0) part[row * 16 + u.pn * 4 + wc] = ss; }
    }
};

__device__ __forceinline__ void p7_final(const Ctx& F) {
    const int gw = F.bid * NWAVES + F.wave, NGW = F.G * NWAVES;
    for (int gi = gw; gi < T_ALL / 16; gi += NGW) {
        const int m0 = gi * 16; int b16, pos; row_info(m0, b16, pos);
        const float* md = F.mod + b16 * 3072 + 2048;
        f32x4 gg[4];
#pragma unroll
        for (int j = 0; j < 4; ++j) { const int c = 4 * F.lane + 256 * j; gg[j] = *(const f32x4*)(F.g_post + c) * *(const f32x4*)(md + c); }
        for (int r = 0; r < 16; ++r) {
            const int m = m0 + r;
            float ss = F.part[(size_t)m * 16 + (F.lane & 15)];
            ss += __shfl_xor(ss, 1); ss += __shfl_xor(ss, 2); ss += __shfl_xor(ss, 4); ss += __shfl_xor(ss, 8);
            const float rstd = rsqrtf(ss * (1.f / DM) + EPS);
            const f32x4* xr = (const f32x4*)x_row(F, m) + F.lane;
            const u32x2* orow = (const u32x2*)(F.OUTB + (size_t)m * DM) + F.lane;
            f32x4* dst = (f32x4*)(F.out + (size_t)m * DM) + F.lane;
#pragma unroll
            for (int j = 0; j < 4; ++j) { const u32x2 ov = orow[64 * j]; const f32x4 xv = xr[64 * j];
                f32x4 y; y.x = xv.x + gg[j].x * (bf_lo(ov.x) * rstd); y.y = xv.y + gg[j].y * (bf_hi(ov.x) * rstd); y.z = xv.z + gg[j].z * (bf_lo(ov.y) * rstd); y.w = xv.w + gg[j].w * (bf_hi(ov.y) * rstd);
                dst[64 * j] = y; }
        }
    }
}

__global__ void __launch_bounds__(NTHR, 2) fwd_megakernel(Args args) {
    extern __shared__ __attribute__((aligned(16))) unsigned char smem[];
    cg::grid_group grid = cg::this_grid();
    LAS unsigned char* lds = (LAS unsigned char*)smem;
    Ctx F;
    F.xp = args.in[0]; F.xs = args.in[1]; F.cp = args.in[2]; F.cs = args.in[3]; F.ada_w = args.in[4]; F.ada_b = args.in[5]; F.g_pre = args.in[6]; F.g_post = args.in[7];
    F.w_in = args.in[8]; F.pool_w = args.in[9]; F.pool_scale = args.in[10]; F.dec_f = args.in[11]; F.dec_b = args.in[12]; F.w_out = args.in[13];
    F.out = args.out; F.ws = args.ws;
    F.mod = (float*)(args.ws + WS_MOD); F.WinT = (bf16_t*)(args.ws + WS_WIN); F.WoutT = (bf16_t*)(args.ws + WS_WOUT); F.part = (float*)(args.ws + WS_PART);
    F.H = (bf16_t*)(args.ws + WS_H); F.U = (bf16_t*)(args.ws + WS_U); F.Q = (bf16_t*)(args.ws + WS_Q); F.Kb = (bf16_t*)(args.ws + WS_K); F.VT = (bf16_t*)(args.ws + WS_VT);
    F.Z = (bf16_t*)args.out; F.KV = (bf16_t*)(args.ws + WS_H); F.OUTB = (bf16_t*)(args.ws + WS_U);
    F.tid = threadIdx.x; F.lane = F.tid & 63; F.wave = __builtin_amdgcn_readfirstlane(F.tid >> 6); F.G = gridDim.x; F.bid = blockIdx.x;
    const int lo = args.ph_lo, hi = args.ph_hi;
#define IN(k) (lo <= (k) && (k) < hi)
#define SEAM(k) do { if (IN(k) && IN((k) + 1)) grid.sync(); } while (0)
    if (IN(0)) { p0_prologue(F, lds); } SEAM(0);
    if (IN(1)) { p1_prenorm(F); } SEAM(1);
    if (IN(2)) { SchedIn S{(const char*)F.H, (const char*)F.WinT, F.G, F.bid}; EpiIn E{F.U, F.Q, F.Kb, F.VT, F.Z}; pg8::gemm_phase<EpiIn, SchedIn>(lds, DM, S, E); } SEAM(2);
    if (IN(3)) { for (int it = F.bid; it < 3072; it += F.G) ra_item(F, it, lds); for (int pt = F.bid; pt < T_ALL / 64; pt += F.G) pool_item(F, pt); } SEAM(3);
    if (IN(4)) { rb_scan(F); } SEAM(4);
    if (IN(5)) { for (int it = F.bid; it < 3072; it += F.G) rc_item(F, it, lds); } SEAM(5);
    if (IN(6)) { SchedOut S{(const char*)F.Z, (const char*)F.WoutT, F.G, F.bid}; EpiOut E{F.OUTB, F.part}; pg8::gemm_phase<EpiOut, SchedOut>(lds, DMIX, S, E); } SEAM(6);
    if (IN(7)) { p7_final(F); }
}

#ifndef N_LAUNCH_MODE
#define N_LAUNCH_MODE 1
#endif

extern "C" void kernel_launch(void* const* d_in, const int* in_sizes, int n_in, void* d_out, int out_size, void* d_ws, size_t ws_size, hipStream_t stream) {
    static int grid = 0;
    if (grid == 0) {
        if (n_in != 14 || out_size != T_ALL * DM || ws_size < WS_END) { fprintf(stderr, "kernel_launch: unexpected shapes (n_in %d out %d ws %zu)\n", n_in, out_size, ws_size); grid = -1; return; }
        int dev = 0, cus = 0, per_cu = 0;
        hipGetDevice(&dev); hipDeviceGetAttribute(&cus, hipDeviceAttributeMultiprocessorCount, dev);
        if (hipFuncSetAttribute((const void*)fwd_megakernel, hipFuncAttributeMaxDynamicSharedMemorySize, LDS_BYTES) != hipSuccess) { fprintf(stderr, "kernel_launch: hipFuncSetAttribute failed\n"); grid = -1; return; }
        if (hipOccupancyMaxActiveBlocksPerMultiprocessor(&per_cu, (const void*)fwd_megakernel, NTHR, LDS_BYTES) != hipSuccess || per_cu < 1) { fprintf(stderr, "kernel_launch: occupancy query says %d\n", per_cu); per_cu = 1; }
        (void)hipGetLastError();
        grid = cus * per_cu;
        fprintf(stderr, "kernel_launch: cus %d per_cu %d grid %d\n", cus, per_cu, grid);
    }
    if (grid < 0) return;
    Args a{};
    for (int i = 0; i < 14; ++i) a.in[i] = (const float*)d_in[i];
    a.out = (float*)d_out; a.ws = (unsigned char*)d_ws;
#if N_LAUNCH_MODE == 1
    a.ph_lo = 0; a.ph_hi = 8;
    void* kargs[] = {&a};
    hipError_t e = hipLaunchCooperativeKernel((const void*)fwd_megakernel, dim3(grid), dim3(NTHR), kargs, LDS_BYTES, stream);
    if (e != hipSuccess) fprintf(stderr, "kernel_launch: cooperative launch failed: %s (grid %d)\n", hipGetErrorString(e), grid);
#else
    for (int p = 0; p < 8; ++p) { a.ph_lo = p; a.ph_hi = p + 1; hipLaunchKernelGGL(fwd_megakernel, dim3(grid), dim3(NTHR), LDS_BYTES, stream, a); }
#endif
}
```

```cpp
#include <hip/hip_runtime.h>
#include <hip/hip_cooperative_groups.h>
#include <cstdio>
#include <cstdint>
namespace cg = cooperative_groups;

#define LAS __attribute__((address_space(3)))
typedef unsigned short bf16_t;
typedef short bf16x8 __attribute__((ext_vector_type(8)));
typedef float f32x4 __attribute__((ext_vector_type(4)));
typedef unsigned u32x4 __attribute__((ext_vector_type(4)));
typedef unsigned u32x2 __attribute__((ext_vector_type(2)));

constexpr int NTHR = 512, NWAVES = 8;
constexpr int DM = 1024, DIN = 6144, DMIX = 2048;
constexpr int T_P = 65536, T_S = 32768, T_ALL = 98304, S_P = 8192, S_S = 4096;
constexpr float EPS = 1e-6f;
constexpr size_t MiB = 1u << 20;
constexpr size_t WS_MOD = 0;
constexpr size_t WS_WIN = 1 * MiB;
constexpr size_t WS_WOUT = 13 * MiB;
constexpr size_t WS_PART = 17 * MiB;
constexpr size_t WS_H = 24 * MiB;
constexpr size_t WS_U = 216 * MiB;
constexpr size_t WS_Q = 408 * MiB;
constexpr size_t WS_K = 600 * MiB;
constexpr size_t WS_VT = 792 * MiB;
constexpr size_t WS_END = 984 * MiB;
constexpr int LDS_BYTES = 147456;

__device__ __forceinline__ unsigned pk_bf16(float lo, float hi) { unsigned r; asm("v_cvt_pk_bf16_f32 %0, %1, %2" : "=v"(r) : "v"(lo), "v"(hi)); return r; }
__device__ __forceinline__ float bf_lo(unsigned u) { return __uint_as_float(u << 16); }
__device__ __forceinline__ float bf_hi(unsigned u) { return __uint_as_float(u & 0xffff0000u); }
__device__ __forceinline__ float wave_sum(float v) {
#pragma unroll
    for (int o = 1; o < 64; o <<= 1) v += __shfl_xor(v, o);
    return v;
}
__device__ __forceinline__ float silu_f(float z) { return z * __builtin_amdgcn_rcpf(1.0f + __builtin_amdgcn_exp2f(-1.4426950408889634f * z)); }
__device__ __forceinline__ void row_info(int m, int& b16, int& pos) { if (m < T_P) { b16 = m >> 13; pos = m & 8191; } else { const int mm = m - T_P; b16 = 8 + (mm >> 12); pos = mm & 4095; } }

namespace pg8 {
constexpr int BM = 256, BK = 64, HALF = 128, HTB = HALF * BK * 2, STAGE_BYTES = 8 * HTB, NXCD = 8, WGM = 8;
__host__ __device__ __forceinline__ int lds_byte(int r, int c) { const int st = (r >> 4) * 2 + (c >> 5), rr = r & 15, cc = c & 31, ob = rr * 64 + cc * 2; return st * 1024 + (ob ^ (((ob >> 9) & 1) << 5)); }
__host__ __device__ __forceinline__ void stage_rc(int b, int& R, int& C) { const int st = b / 1024, sb = b % 1024, swz = sb ^ (((sb >> 9) & 1) << 5); R = (st >> 1) * 16 + swz / 64; C = (st & 1) * 32 + (swz % 64) / 2; }
__host__ __device__ __forceinline__ int perm32(int rho) { const int n = rho >> 4, i = rho & 15; return 8 * (i >> 2) + 4 * n + (i & 3); }

struct Unit { const char* a; const char* b; int pm, pn; };

__device__ __forceinline__ bool order_next(int i, int G, int c, int nM, int nN, int& pm, int& pn) {
    const int nwg = nM * nN; const long L = (long)i * G + c; if (L >= nwg) return false;
    int wgid = (int)L; { const int q = nwg / NXCD, r = nwg % NXCD, xcd = wgid % NXCD, off = wgid / NXCD; wgid = (xcd < r ? xcd * (q + 1) : r * (q + 1) + (xcd - r) * q) + off; }
    const int nig = WGM * nN, gid = wgid / nig, fm = gid * WGM, gsz = (nM - fm) < WGM ? (nM - fm) : WGM;
    pm = fm + ((wgid % nig) % gsz); pn = (wgid % nig) / gsz; return true;
}

template <class Epi, class Sched>
__device__ __forceinline__ void gemm_phase(LAS unsigned char* lds, const int K, const Sched& S, const Epi& E) {
    const int tid = threadIdx.x, wid = __builtin_amdgcn_readfirstlane(tid >> 6), lane = tid & 63, wr = wid >> 2, wc = wid & 3, fr = lane & 15, fq = lane >> 4;
    const int nt = K / BK;
    unsigned voffA[2], voffB[2];
#pragma unroll
    for (int i = 0; i < 2; ++i) { int R, C; stage_rc(tid * 16 + i * 8192, R, C); const int Rb = (R & ~31) + perm32(R & 31);
        voffA[i] = (unsigned)(R * K + C) * 2u; voffB[i] = (unsigned)(Rb * K + C) * 2u; }
    const size_t kstep = (size_t)(BK * 2);
    const size_t hstep = (size_t)HALF * K * 2;
    const unsigned ldsw = (unsigned)wid * 1024u;
    const int aoff = lds_byte(wr * 64 + fr, fq * 8), boff = lds_byte(wc * 32 + fr, fq * 8);
#define PG8_SA(b, h) (((b) * 2 + (h)) * HTB)
#define PG8_SB(b, h) ((4 + (b) * 2 + (h)) * HTB)
#define PG8_STAGE(bufoff, gbase, voff) do { _Pragma("unroll") for (int _i = 0; _i < 2; ++_i) \
        __builtin_amdgcn_global_load_lds((const unsigned*)((const char*)(gbase) + (voff)[_i]), (LAS unsigned*)(lds + (bufoff) + ldsw + _i * 8192), 16, 0, 0); } while (0)
#define PG8_LDA(dst, b, h) do { _Pragma("unroll") for (int m = 0; m < 4; ++m) _Pragma("unroll") for (int k = 0; k < 2; ++k) dst[m][k] = *(const LAS bf16x8*)(lds + PG8_SA(b, h) + aoff + m * 2048 + k * 1024); } while (0)
#define PG8_LDB(dst, b, h) do { _Pragma("unroll") for (int n = 0; n < 2; ++n) _Pragma("unroll") for (int k = 0; k < 2; ++k) dst[n][k] = *(const LAS bf16x8*)(lds + PG8_SB(b, h) + boff + n * 2048 + k * 1024); } while (0)
#define PG8_MMA(ai, bj, At, Bt) do { __builtin_amdgcn_s_setprio(1); _Pragma("unroll") for (int m = 0; m < 4; ++m) _Pragma("unroll") for (int n = 0; n < 2; ++n) _Pragma("unroll") for (int k = 0; k < 2; ++k) \
        acc[ai][bj][m][n] = __builtin_amdgcn_mfma_f32_16x16x32_bf16(Bt[n][k], At[m][k], acc[ai][bj][m][n], 0, 0, 0); __builtin_amdgcn_s_setprio(0); } while (0)
#define PG8_WAIT_V(n) asm volatile("s_waitcnt vmcnt(" #n ")" ::: "memory")
#define PG8_WAIT_L(n) asm volatile("s_waitcnt lgkmcnt(" #n ")" ::: "memory")
#define PG8_BAR __builtin_amdgcn_s_barrier()
#define PG8_SCHED __builtin_amdgcn_sched_barrier(0)
    Unit cur, nxt; int ui = 0;
    if (!S.next(0, cur)) return;
    f32x4 acc[2][2][4][2];
#pragma unroll
    for (int a = 0; a < 2; ++a)
#pragma unroll
        for (int b = 0; b < 2; ++b)
#pragma unroll
            for (int m = 0; m < 4; ++m)
#pragma unroll
                for (int n = 0; n < 2; ++n) acc[a][b][m][n] = (f32x4){0.f, 0.f, 0.f, 0.f};
    bf16x8 At[4][2], B0[2][2], B1[2][2];
    const char* cA = cur.a; const char* cB = cur.b;
    PG8_STAGE(PG8_SB(0, 0), cB, voffB); PG8_STAGE(PG8_SB(0, 1), cB + hstep, voffB); PG8_STAGE(PG8_SA(0, 0), cA, voffA); PG8_STAGE(PG8_SA(0, 1), cA + hstep, voffA);
    if (wr == 1) PG8_BAR;
    PG8_WAIT_V(2); PG8_BAR;
    PG8_STAGE(PG8_SB(1, 0), cB + kstep, voffB); PG8_STAGE(PG8_SA(1, 0), cA + kstep, voffA); PG8_STAGE(PG8_SB(1, 1), cB + hstep + kstep, voffB);
    PG8_WAIT_V(6); PG8_BAR;
    for (;;) {
        const bool has_next = S.next(ui + 1, nxt);
        const char* nA = has_next ? nxt.a : cA; const char* nB = has_next ? nxt.b : cB;
        for (int t = 0; t < nt; t += 2) {
            const bool last = (t == nt - 2);
            const char* a1 = cA + (size_t)(t + 1) * kstep;
            const char* a2 = last ? nA : cA + (size_t)(t + 2) * kstep; const char* b2 = last ? nB : cB + (size_t)(t + 2) * kstep;
            const char* a3 = a2 + kstep; const char* b3 = b2 + kstep;
            PG8_LDB(B0, 0, 0); PG8_LDB(B1, 0, 1); PG8_SCHED; PG8_LDA(At, 0, 0); PG8_STAGE(PG8_SA(1, 1), a1 + hstep, voffA);
            PG8_WAIT_V(8); PG8_WAIT_L(0); PG8_BAR; PG8_MMA(0, 0, At, B0); PG8_MMA(0, 1, At, B1); PG8_BAR; PG8_SCHED;
            PG8_LDA(At, 0, 1); PG8_STAGE(PG8_SB(0, 0), b2, voffB); PG8_STAGE(PG8_SB(0, 1), b2 + hstep, voffB); PG8_STAGE(PG8_SA(0, 0), a2, voffA);
            PG8_WAIT_V(8); PG8_WAIT_L(0); PG8_BAR; PG8_MMA(1, 0, At, B0); PG8_MMA(1, 1, At, B1); PG8_BAR; PG8_SCHED;
            PG8_LDB(B0, 1, 0); PG8_LDB(B1, 1, 1); PG8_SCHED; PG8_LDA(At, 1, 0); PG8_STAGE(PG8_SA(0, 1), a2 + hstep, voffA);
            PG8_WAIT_V(8); PG8_WAIT_L(0); PG8_BAR; PG8_MMA(0, 0, At, B0); PG8_MMA(0, 1, At, B1); PG8_BAR; PG8_SCHED;
            PG8_LDA(At, 1, 1); PG8_STAGE(PG8_SB(1, 0), b3, voffB); PG8_STAGE(PG8_SB(1, 1), b3 + hstep, voffB); PG8_STAGE(PG8_SA(1, 0), a3, voffA);
            PG8_WAIT_V(8); PG8_WAIT_L(0); PG8_BAR; PG8_MMA(1, 0, At, B0); PG8_MMA(1, 1, At, B1); PG8_BAR; PG8_SCHED;
        }
        if (wr == 0) PG8_BAR;
        E(acc, cur, wr, wc, fr, fq);
        if (!has_next) break;
#pragma unroll
        for (int a = 0; a < 2; ++a)
#pragma unroll
            for (int b = 0; b < 2; ++b)
#pragma unroll
                for (int m = 0; m < 4; ++m)
#pragma unroll
                    for (int n = 0; n < 2; ++n) acc[a][b][m][n] = (f32x4){0.f, 0.f, 0.f, 0.f};
        cur = nxt; cA = nA; cB = nB; ++ui;
        if (wr == 1) PG8_BAR;
    }
    PG8_WAIT_V(0);
    PG8_BAR;
#undef PG8_SA
#undef PG8_SB
#undef PG8_STAGE
#undef PG8_LDA
#undef PG8_LDB
#undef PG8_MMA
#undef PG8_WAIT_V
#undef PG8_WAIT_L
#undef PG8_BAR
#undef PG8_SCHED
}
}

struct Args { const float* in[14]; float* out; unsigned char* ws; int ph_lo, ph_hi; };

struct Ctx {
    const float *xp, *xs, *cp, *cs, *ada_w, *ada_b, *g_pre, *g_post, *w_in, *pool_w, *pool_scale, *dec_f, *dec_b, *w_out;
    float* out; unsigned char* ws;
    float* mod; bf16_t *WinT, *WoutT; float* part; bf16_t *H, *U, *Q, *Kb, *VT, *Z, *KV, *OUTB;
    int tid, lane, wave, G, bid;
};
__device__ __forceinline__ const float* x_row(const Ctx& F, int m) { return m < T_P ? F.xp + (size_t)m * DM : F.xs + (size_t)(m - T_P) * DM; }

__device__ __forceinline__ int colmap(int rho) {
    const int pn = rho >> 8;
    if (pn < 4 || pn >= 12) return rho;
    const int s = rho & 255, bj = s >> 7, sp = s & 127;
    return 1024 * (pn >> 2) + (2 * (pn & 3) + (sp >> 6)) * 128 + 64 * bj + (sp & 63);
}
__device__ __forceinline__ void p0_write_tile(bf16_t* WT, int Kdst, int row0, int k0, LAS float* scr, int lane) {
    asm volatile("s_waitcnt lgkmcnt(0)" ::: "memory");
    const int c = lane & 7;
#pragma unroll
    for (int j = 0; j < 4; ++j) { const int n = (lane >> 3) + 8 * j; const LAS float* s = scr + (8 * c) * 33 + n;
        u32x4 o; o.x = pk_bf16(s[0 * 33], s[1 * 33]); o.y = pk_bf16(s[2 * 33], s[3 * 33]); o.z = pk_bf16(s[4 * 33], s[5 * 33]); o.w = pk_bf16(s[6 * 33], s[7 * 33]);
        *(u32x4*)(WT + (size_t)(row0 + n) * Kdst + k0 + 8 * c) = o; }
    asm volatile("s_waitcnt lgkmcnt(0)" ::: "memory");
}
__device__ __forceinline__ void p0_transpose_item(const float* W, int N, int k0, int n0src, bf16_t* WT, int Kdst, int row0, LAS float* scr, int lane) {
#pragma unroll 8
    for (int i = 0; i < 32; ++i) { const int kk = 2 * i + (lane >> 5); scr[kk * 33 + (lane & 31)] = W[(size_t)(k0 + kk) * N + n0src + (lane & 31)]; }
    p0_write_tile(WT, Kdst, row0, k0, scr, lane);
}
__device__ __forceinline__ void p0_fold_item(const Ctx& F, int item, LAS float* scr, int lane) {
    const int kb = item >> 5, nb = item & 31, k0 = 64 * kb, rho0 = 32 * nb, g = rho0 >> 8, d0 = rho0 & 255;
    const int kl = lane >> 3, dg = lane & 7;
    f32x4 acc[8];
#pragma unroll
    for (int q = 0; q < 8; ++q) acc[q] = (f32x4){0.f, 0.f, 0.f, 0.f};
    const float* pw0 = F.pool_w + (size_t)g * 65536 + d0 + 4 * dg;
    const float* wi0 = F.w_in + (size_t)(k0 + kl) * DIN + g * 256;
    for (int c = 0; c < 256; c += 4) {
        f32x4 pw[4];
#pragma unroll
        for (int cc = 0; cc < 4; ++cc) pw[cc] = *(const f32x4*)(pw0 + (size_t)(c + cc) * 256);
#pragma unroll
        for (int q = 0; q < 8; ++q) { const f32x4 wv = *(const f32x4*)(wi0 + (size_t)(8 * q) * DIN + c);
            acc[q] += wv.x * pw[0] + wv.y * pw[1] + wv.z * pw[2] + wv.w * pw[3]; }
    }
#pragma unroll
    for (int q = 0; q < 8; ++q)
#pragma unroll
        for (int e = 0; e < 4; ++e) scr[(kl + 8 * q) * 33 + 4 * dg + e] = acc[q][e];
    p0_write_tile(F.WinT, DM, rho0, k0, scr, lane);
}
__device__ __forceinline__ void p0_prologue(const Ctx& F, LAS unsigned char* lds) {
    LAS float* scr = (LAS float*)(lds + F.wave * 16384);
    if (F.bid < 48) {
        LAS float* sv = scr; LAS float* red = (LAS float*)(lds + F.wave * 16384 + 12288);
        const int kw0 = 128 * F.wave;
        for (int idx = F.lane; idx < 2048; idx += 64) { const int r = idx >> 7, kk = idx & 127;
            const float c = r < 8 ? F.cp[r * DM + kw0 + kk] : F.cs[(r - 8) * DM + kw0 + kk]; sv[idx] = silu_f(c); }
        asm volatile("s_waitcnt lgkmcnt(0)" ::: "memory");
        float a16[16];
#pragma unroll
        for (int r = 0; r < 16; ++r) a16[r] = 0.f;
        const float* wp = F.ada_w + (size_t)kw0 * 3072 + 64 * F.bid + F.lane;
        for (int kk = 0; kk < 128; ++kk) { const float wv = wp[(size_t)kk * 3072];
#pragma unroll
            for (int r = 0; r < 16; ++r) a16[r] += sv[r * 128 + kk] * wv; }
#pragma unroll
        for (int r = 0; r < 16; ++r) red[r * 64 + F.lane] = a16[r];
        __syncthreads();
        for (int o = F.tid; o < 1024; o += NTHR) { const int r = o >> 6, col = o & 63; float s = F.ada_b[64 * F.bid + col];
#pragma unroll
            for (int w = 0; w < 8; ++w) s += *((LAS float*)(lds + w * 16384 + 12288) + r * 64 + col);
            F.mod[r * 3072 + 64 * F.bid + col] = s; }
    }
    const int gw = F.bid * NWAVES + F.wave, NGW = F.G * NWAVES;
    constexpr int I_FOLD = 512, I_IN = 16 * 160, I_OUT = 32 * 32;
    for (int it = gw; it < I_FOLD + I_IN + I_OUT; it += NGW) {
        int r = it;
        if (r < I_FOLD) { p0_fold_item(F, r, scr, F.lane); continue; } r -= I_FOLD;
        if (r < I_IN) { const int kb = r / 160, nb = r % 160, rho0 = 1024 + 32 * nb; p0_transpose_item(F.w_in, DIN, 64 * kb, colmap(rho0), F.WinT, DM, rho0, scr, F.lane); continue; } r -= I_IN;
        { const int kb = r >> 5, nb = r & 31; p0_transpose_item(F.w_out, DM, 64 * kb, 32 * nb, F.WoutT, DMIX, 32 * nb, scr, F.lane); }
    }
}

__device__ __forceinline__ void p1_prenorm(const Ctx& F) {
    const int gw = F.bid * NWAVES + F.wave, NGW = F.G * NWAVES;
    for (int gi = gw; gi < T_ALL / 16; gi += NGW) {
        const int m0 = gi * 16; int b16, pos; row_info(m0, b16, pos);
        const float* md = F.mod + b16 * 3072;
        f32x4 ga[4], sh[4];
#pragma unroll
        for (int j = 0; j < 4; ++j) { const int c = 4 * F.lane + 256 * j; const f32x4 g = *(const f32x4*)(F.g_pre + c), sc = *(const f32x4*)(md + 1024 + c);
            ga[j] = g * (sc + 1.0f); sh[j] = *(const f32x4*)(md + c); }
        for (int r = 0; r < 16; ++r) {
            const f32x4* xr = (const f32x4*)x_row(F, m0 + r) + F.lane;
            f32x4 v[4]; float s = 0.f;
#pragma unroll
            for (int j = 0; j < 4; ++j) { v[j] = xr[64 * j]; s += (v[j].x * v[j].x + v[j].y * v[j].y) + (v[j].z * v[j].z + v[j].w * v[j].w); }
            const float rstd = rsqrtf(wave_sum(s) * (1.f / DM) + EPS);
            u32x2* o8 = (u32x2*)(F.H + (size_t)(m0 + r) * DM) + F.lane;
#pragma unroll
            for (int j = 0; j < 4; ++j) { const f32x4 y = v[j] * rstd * ga[j] + sh[j]; u32x2 w; w.x = pk_bf16(y.x, y.y); w.y = pk_bf16(y.z, y.w); o8[64 * j] = w; }
        }
    }
}

struct SchedIn {
    const char* H; const char* W; int G, c;
    __device__ __forceinline__ bool next(int i, pg8::Unit& u) const {
        int pm, pn; if (!pg8::order_next(i, G, c, T_ALL / 256, DIN / 256, pm, pn)) return false;
        const size_t tstep = (size_t)256 * DM * 2; const char* hp = H + (size_t)pm * tstep; const char* wp = W + (size_t)pn * tstep;
        const bool sw = (pn >= 12 && pn < 16);
        u.a = sw ? wp : hp; u.b = sw ? hp : wp; u.pm = pm; u.pn = pn; return true;
    }
};
struct EpiIn {
    bf16_t *U, *Q, *Kb, *VT, *Z;
    __device__ __forceinline__ void operator()(const f32x4 (&acc)[2][2][4][2], const pg8::Unit& u, int wr, int wc, int fr, int fq) const {
        const int pm = u.pm, pn = u.pn;
        if (pn < 4) {
#pragma unroll
            for (int ai = 0; ai < 2; ++ai)
#pragma unroll
                for (int m = 0; m < 4; ++m) { bf16_t* rp = U + (size_t)(pm * 256 + ai * 128 + wr * 64 + m * 16 + fr) * DM + pn * 256 + wc * 32 + 8 * fq;
#pragma unroll
                    for (int bj = 0; bj < 2; ++bj) { const f32x4 v0 = acc[ai][bj][m][0], v1 = acc[ai][bj][m][1];
                        u32x4 w; w.x = pk_bf16(v0[0], v0[1]); w.y = pk_bf16(v0[2], v0[3]); w.z = pk_bf16(v1[0], v1[1]); w.w = pk_bf16(v1[2], v1[3]);
                        *(u32x4*)(rp + bj * 128) = w; } }
        } else if (pn < 12) {
            const bool isk = pn >= 8; bf16_t* base = isk ? Kb : Q; const float scl = isk ? 0.08838834764831845f : 1.0f;
            const int head = 2 * (pn & 3) + (wc >> 1), dlo = 32 * (wc & 1) + 8 * fq;
            const int pos0 = pm < 256 ? (pm & 31) * 256 : ((pm - 256) & 15) * 256;
            float cf[8];
#pragma unroll
            for (int e = 0; e < 8; ++e) cf[e] = __builtin_amdgcn_exp2f(-(float)(dlo + e) * 0.20762050593046014f) * 0.15915494309189535f;
#pragma unroll
            for (int ai = 0; ai < 2; ++ai)
#pragma unroll
                for (int m = 0; m < 4; ++m) {
                    const int rl = ai * 128 + wr * 64 + m * 16 + fr; const float fpos = (float)(pos0 + rl);
                    float o1[8], o2[8];
#pragma unroll
                    for (int e = 0; e < 8; ++e) {
                        const float rev = fpos * cf[e]; const float fr_ = __builtin_amdgcn_fractf(rev);
                        const float sn = __builtin_amdgcn_sinf(fr_), cs = __builtin_amdgcn_cosf(fr_);
                        const float x1 = acc[ai][0][m][e >> 2][e & 3], x2 = acc[ai][1][m][e >> 2][e & 3];
                        o1[e] = (x1 * cs - x2 * sn) * scl; o2[e] = (x2 * cs + x1 * sn) * scl;
                    }
                    bf16_t* rp = base + (size_t)(pm * 256 + rl) * DM + head * 128 + dlo;
                    u32x4 w1, w2; w1.x = pk_bf16(o1[0], o1[1]); w1.y = pk_bf16(o1[2], o1[3]); w1.z = pk_bf16(o1[4], o1[5]); w1.w = pk_bf16(o1[6], o1[7]);
                    w2.x = pk_bf16(o2[0], o2[1]); w2.y = pk_bf16(o2[2], o2[3]); w2.z = pk_bf16(o2[4], o2[5]); w2.w = pk_bf16(o2[6], o2[7]);
                    *(u32x4*)rp = w1; *(u32x4*)(rp + 64) = w2;
                }
        } else if (pn < 16) {
            int b, t0, S; size_t gbase;
            if (pm < 256) { b = pm >> 5; t0 = (pm & 31) * 256; S = S_P; gbase = 0; } else { const int q = pm - 256; b = q >> 4; t0 = (q & 15) * 256; S = S_S; gbase = (size_t)64 * 128 * S_P; }
#pragma unroll
            for (int ai = 0; ai < 2; ++ai)
#pragma unroll
                for (int m = 0; m < 4; ++m) { const int head = 2 * (pn - 12) + ai, dv = wr * 64 + m * 16 + fr;
                    bf16_t* rp = VT + gbase + ((size_t)(b * 8 + head) * 128 + dv) * S + t0 + wc * 32 + 8 * fq;
#pragma unroll
                    for (int bj = 0; bj < 2; ++bj) { const f32x4 v0 = acc[ai][bj][m][0], v1 = acc[ai][bj][m][1];
                        u32x4 w; w.x = pk_bf16(v0[0], v0[1]); w.y = pk_bf16(v0[2], v0[3]); w.z = pk_bf16(v1[0], v1[1]); w.w = pk_bf16(v1[2], v1[3]);
                        *(u32x4*)(rp + bj * 128) = w; } }
        } else {
#pragma unroll
            for (int ai = 0; ai < 2; ++ai)
#pragma unroll
                for (int m = 0; m < 4; ++m) { bf16_t* rp = Z + (size_t)(pm * 256 + ai * 128 + wr * 64 + m * 16 + fr) * DMIX + (pn - 16) * 256 + wc * 32 + 8 * fq;
#pragma unroll
                    for (int bj = 0; bj < 2; ++bj) { const f32x4 v0 = acc[ai][bj][m][0], v1 = acc[ai][bj][m][1];
                        u32x4 w; w.x = pk_bf16(silu_f(v0[0]), silu_f(v0[1])); w.y = pk_bf16(silu_f(v0[2]), silu_f(v0[3])); w.z = pk_bf16(silu_f(v1[0]), silu_f(v1[1])); w.w = pk_bf16(silu_f(v1[2]), silu_f(v1[3]));
                        *(u32x4*)(rp + bj * 128) = w; } }
        }
    }
};

struct RItem { int S, m0, h, nsc, sc; const bf16_t* vt; };
__device__ __forceinline__ RItem ritem(const Ctx& F, int it) {
    RItem r;
    if (it < 2048) { const int bh = it >> 5; r.sc = it & 31; r.S = S_P; r.nsc = 32; r.h = bh & 7; r.m0 = (bh >> 3) * S_P + r.sc * 256; r.vt = F.VT + (size_t)bh * 128 * S_P + r.sc * 256; }
    else { const int q = it - 2048, bh = q >> 4; r.sc = q & 15; r.S = S_S; r.nsc = 16; r.h = bh & 7; r.m0 = T_P + (bh >> 3) * S_S + r.sc * 256; r.vt = F.VT + (size_t)64 * 128 * S_P + (size_t)bh * 128 * S_S + r.sc * 256; }
    return r;
}
__device__ __forceinline__ float log2_gamma(const float* dec, int h) { return log1pf(-exp2f(-dec[h])) * 1.4426950408889634f; }

__device__ __forceinline__ void ra_item(const Ctx& F, int it, LAS unsigned char* lds) {
    const RItem R = ritem(F, it);
    const int tid = F.tid, w = F.wave, lane = F.lane, l15 = lane & 15, g = lane >> 4;
    LAS unsigned char* Kl = lds;
    LAS unsigned char* Vl = lds + 69632;
#pragma unroll
    for (int p = 0; p < 8; ++p) { const int idx = p * NTHR + tid, row = idx >> 4, c = idx & 15;
        const u32x4 v = *(const u32x4*)(F.Kb + (size_t)(R.m0 + row) * DM + R.h * 128 + c * 8);
        LAS u32x2* d = (LAS u32x2*)(Kl + row * 264 + c * 16); d[0] = (u32x2){v.x, v.y}; d[1] = (u32x2){v.z, v.w}; }
#pragma unroll
    for (int p = 0; p < 8; ++p) { const int idx = p * NTHR + tid, row = idx >> 5, c = idx & 31;
        const u32x4 v = *(const u32x4*)(R.vt + (size_t)row * R.S + c * 8);
        *(LAS u32x4*)(Vl + row * 528 + c * 16) = v; }
    __syncthreads();
    const int dir = w >> 2, dk0 = (w & 3) * 32;
    const float lg2 = log2_gamma(dir ? F.dec_b : F.dec_f, R.h);
    f32x4 acc[2][8];
#pragma unroll
    for (int mt = 0; mt < 2; ++mt)
#pragma unroll
        for (int nt = 0; nt < 8; ++nt) acc[mt][nt] = (f32x4){0.f, 0.f, 0.f, 0.f};
    const LAS bf16_t* Ks = (const LAS bf16_t*)Kl;
#pragma unroll 2
    for (int kk = 0; kk < 8; ++kk) {
        float wj[8];
#pragma unroll
        for (int e = 0; e < 8; ++e) { const int j = 32 * kk + 8 * g + e; wj[e] = __builtin_amdgcn_exp2f(lg2 * (float)(dir ? j : 255 - j)); }
        bf16x8 af[2];
#pragma unroll
        for (int mt = 0; mt < 2; ++mt) { const int dk = dk0 + 16 * mt + l15; float t[8];
#pragma unroll
            for (int e = 0; e < 8; ++e) t[e] = __uint_as_float((unsigned)Ks[(32 * kk + 8 * g + e) * 132 + dk] << 16) * wj[e];
            u32x4 pa; pa.x = pk_bf16(t[0], t[1]); pa.y = pk_bf16(t[2], t[3]); pa.z = pk_bf16(t[4], t[5]); pa.w = pk_bf16(t[6], t[7]);
            af[mt] = __builtin_bit_cast(bf16x8, pa); }
#pragma unroll
        for (int nt = 0; nt < 8; ++nt) { const bf16x8 bfr = *(const LAS bf16x8*)(Vl + (16 * nt + l15) * 528 + (32 * kk + 8 * g) * 2);
#pragma unroll
            for (int mt = 0; mt < 2; ++mt) acc[mt][nt] = __builtin_amdgcn_mfma_f32_16x16x32_bf16(af[mt], bfr, acc[mt][nt], 0, 0, 0); }
    }
    bf16_t* kv = F.KV + (size_t)it * 32768 + dir * 16384;
#pragma unroll
    for (int mt = 0; mt < 2; ++mt)
#pragma unroll
        for (int nt = 0; nt < 8; ++nt) { const f32x4 v = acc[mt][nt]; u32x2 o; o.x = pk_bf16(v[0], v[1]); o.y = pk_bf16(v[2], v[3]);
            *(u32x2*)(kv + (16 * nt + l15) * 128 + dk0 + 16 * mt + 4 * g) = o; }
    __syncthreads();
}

__device__ __forceinline__ void pool_item(const Ctx& F, int pt) {
    const int cg8 = F.tid & 127, tq = F.tid >> 7, ch = 8 * cg8, half = 1 << (cg8 >> 5);
    const int m0 = pt * 64 + tq * 16; int b16, pos0; row_info(m0, b16, pos0);
    const int S = m0 < T_P ? S_P : S_S; const int mseq = m0 - pos0;
    const bf16_t* ub = F.U + (size_t)mseq * DM + ch;
    float ps[8];
    { const f32x4 a = *(const f32x4*)(F.pool_scale + ch), b = *(const f32x4*)(F.pool_scale + ch + 4); ps[0] = a.x; ps[1] = a.y; ps[2] = a.z; ps[3] = a.w; ps[4] = b.x; ps[5] = b.y; ps[6] = b.z; ps[7] = b.w; }
    float sum[8];
#pragma unroll
    for (int e = 0; e < 8; ++e) sum[e] = 0.f;
    { const int lo = max(pos0 - half, 0), hi = min(pos0 + half, S);
      for (int s = lo; s < hi; ++s) { const u32x4 v = *(const u32x4*)(ub + (size_t)s * DM);
          sum[0] += bf_lo(v.x); sum[1] += bf_hi(v.x); sum[2] += bf_lo(v.y); sum[3] += bf_hi(v.y); sum[4] += bf_lo(v.z); sum[5] += bf_hi(v.z); sum[6] += bf_lo(v.w); sum[7] += bf_hi(v.w); } }
    for (int r = 0; r < 16; ++r) {
        const int pos = pos0 + r;
        if (r > 0) {
            const int add = pos + half - 1, rem = pos - 1 - half;
            if (add < S) { const u32x4 v = *(const u32x4*)(ub + (size_t)add * DM);
                sum[0] += bf_lo(v.x); sum[1] += bf_hi(v.x); sum[2] += bf_lo(v.y); sum[3] += bf_hi(v.y); sum[4] += bf_lo(v.z); sum[5] += bf_hi(v.z); sum[6] += bf_lo(v.w); sum[7] += bf_hi(v.w); }
            if (rem >= 0) { const u32x4 v = *(const u32x4*)(ub + (size_t)rem * DM);
                sum[0] -= bf_lo(v.x); sum[1] -= bf_hi(v.x); sum[2] -= bf_lo(v.y); sum[3] -= bf_hi(v.y); sum[4] -= bf_lo(v.z); sum[5] -= bf_hi(v.z); sum[6] -= bf_lo(v.w); sum[7] -= bf_hi(v.w); }
        }
        const int lo = max(pos - half, 0), hi = min(pos + half, S); const float inv = 1.0f / (float)(hi - lo);
        const u32x4 c = *(const u32x4*)(ub + (size_t)pos * DM);
        bf16_t* zp = F.Z + (size_t)(mseq + pos) * DMIX + ch;
        const u32x4 z = *(const u32x4*)zp;
        float y[8];
        y[0] = (sum[0] * inv - bf_lo(c.x)) * ps[0] * bf_lo(z.x); y[1] = (sum[1] * inv - bf_hi(c.x)) * ps[1] * bf_hi(z.x);
        y[2] = (sum[2] * inv - bf_lo(c.y)) * ps[2] * bf_lo(z.y); y[3] = (sum[3] * inv - bf_hi(c.y)) * ps[3] * bf_hi(z.y);
        y[4] = (sum[4] * inv - bf_lo(c.z)) * ps[4] * bf_lo(z.z); y[5] = (sum[5] * inv - bf_hi(c.z)) * ps[5] * bf_hi(z.z);
        y[6] = (sum[6] * inv - bf_lo(c.w)) * ps[6] * bf_lo(z.w); y[7] = (sum[7] * inv - bf_hi(c.w)) * ps[7] * bf_hi(z.w);
        u32x4 o; o.x = pk_bf16(y[0], y[1]); o.y = pk_bf16(y[2], y[3]); o.z = pk_bf16(y[4], y[5]); o.w = pk_bf16(y[6], y[7]);
        *(u32x4*)zp = o;
    }
}

__device__ __forceinline__ void rb_scan(const Ctx& F) {
    for (int q = F.bid; q < 1024; q += F.G) {
        const int seq = q >> 3, dir = (q >> 2) & 1, quarter = q & 3;
        const int nsc = seq < 64 ? 32 : 16, it0 = seq < 64 ? seq * 32 : 2048 + (seq - 64) * 16, h = seq & 7;
        const float Gd = __builtin_amdgcn_exp2f(256.0f * log2_gamma(dir ? F.dec_b : F.dec_f, h));
        bf16_t* base = F.KV + (size_t)it0 * 32768 + dir * 16384 + quarter * 4096 + F.tid * 8;
        float st[8];
#pragma unroll
        for (int e = 0; e < 8; ++e) st[e] = 0.f;
        for (int s0 = 0; s0 < nsc; s0 += 4) {
            u32x4 v[4];
#pragma unroll
            for (int u = 0; u < 4; ++u) { const int sc = dir ? nsc - 1 - (s0 + u) : s0 + u; v[u] = *(const u32x4*)(base + (size_t)sc * 32768); }
#pragma unroll
            for (int u = 0; u < 4; ++u) { const int sc = dir ? nsc - 1 - (s0 + u) : s0 + u;
                u32x4 o; o.x = pk_bf16(st[0], st[1]); o.y = pk_bf16(st[2], st[3]); o.z = pk_bf16(st[4], st[5]); o.w = pk_bf16(st[6], st[7]);
                *(u32x4*)(base + (size_t)sc * 32768) = o;
                st[0] = st[0] * Gd + bf_lo(v[u].x); st[1] = st[1] * Gd + bf_hi(v[u].x); st[2] = st[2] * Gd + bf_lo(v[u].y); st[3] = st[3] * Gd + bf_hi(v[u].y);
                st[4] = st[4] * Gd + bf_lo(v[u].z); st[5] = st[5] * Gd + bf_hi(v[u].z); st[6] = st[6] * Gd + bf_lo(v[u].w); st[7] = st[7] * Gd + bf_hi(v[u].w); }
        }
    }
}

template <bool DUMMY>
__device__ __forceinline__ void rc_item(const Ctx& F, int it, LAS unsigned char* lds) {
    const RItem R = ritem(F, it);
    const int tid = F.tid, w = F.wave, lane = F.lane, l15 = lane & 15, g = lane >> 4;
    LAS unsigned char* Kl = lds;
    LAS unsigned char* Vl = lds + 69632;
    LAS float* tab = (LAS float*)(lds + 137216);
    const float lg2f = log2_gamma(F.dec_f, R.h), lg2b = log2_gamma(F.dec_b, R.h);
#pragma unroll
    for (int p = 0; p < 8; ++p) { const int idx = p * NTHR + tid, row = idx >> 4, c = idx & 15;
        *(LAS u32x4*)(Kl + row * 272 + c * 16) = *(const u32x4*)(F.Kb + (size_t)(R.m0 + row) * DM + R.h * 128 + c * 8); }
#pragma unroll
    for (int p = 0; p < 8; ++p) { const int idx = p * NTHR + tid, row = idx >> 5, c = idx & 31;
        *(LAS u32x4*)(Vl + row * 528 + c * 16) = *(const u32x4*)(R.vt + (size_t)row * R.S + c * 8); }
    tab[tid] = tid < 256 ? __builtin_amdgcn_exp2f(-lg2f * (float)tid) : __builtin_amdgcn_exp2f(lg2b * (float)(tid - 256));
    bf16x8 qf[2][4];
#pragma unroll
    for (int n2 = 0; n2 < 2; ++n2)
#pragma unroll
        for (int kk = 0; kk < 4; ++kk) qf[n2][kk] = *(const bf16x8*)(F.Q + (size_t)(R.m0 + 32 * w + 16 * n2 + l15) * DM + R.h * 128 + 32 * kk + 8 * g);
    __syncthreads();
    bf16x8 pf[8][2];
    {
        float fa[2], ba[2]; int irow[2];
#pragma unroll
        for (int n2 = 0; n2 < 2; ++n2) { irow[n2] = 32 * w + 16 * n2 + l15; fa[n2] = __builtin_amdgcn_exp2f(lg2f * (float)irow[n2]); ba[n2] = __builtin_amdgcn_exp2f(-lg2b * (float)irow[n2]); }
#pragma unroll
        for (int k2 = 0; k2 < 8; ++k2) {
            f32x4 s[2][2];
#pragma unroll
            for (int jj = 0; jj < 2; ++jj)
#pragma unroll
                for (int n2 = 0; n2 < 2; ++n2) s[jj][n2] = (f32x4){0.f, 0.f, 0.f, 0.f};
#pragma unroll
            for (int jj = 0; jj < 2; ++jj)
#pragma unroll
                for (int kk = 0; kk < 4; ++kk) { const bf16x8 a = *(const LAS bf16x8*)(Kl + (16 * (2 * k2 + jj) + l15) * 272 + (32 * kk + 8 * g) * 2);
#pragma unroll
                    for (int n2 = 0; n2 < 2; ++n2) s[jj][n2] = __builtin_amdgcn_mfma_f32_16x16x32_bf16(a, qf[n2][kk], s[jj][n2], 0, 0, 0); }
            f32x4 tf[2], tb[2];
#pragma unroll
            for (int jj = 0; jj < 2; ++jj) { tf[jj] = *(const LAS f32x4*)(tab + 32 * k2 + 16 * jj + 4 * g); tb[jj] = *(const LAS f32x4*)(tab + 256 + 32 * k2 + 16 * jj + 4 * g); }
#pragma unroll
            for (int n2 = 0; n2 < 2; ++n2) { float p[8];
#pragma unroll
                for (int jj = 0; jj < 2; ++jj)
#pragma unroll
                    for (int r = 0; r < 4; ++r) { const int j = 32 * k2 + 16 * jj + 4 * g + r; const float d = (j <= irow[n2]) ? fa[n2] * tf[jj][r] : ba[n2] * tb[jj][r]; p[4 * jj + r] = s[jj][n2][r] * d; }
                u32x4 pp; pp.x = pk_bf16(p[0], p[1]); pp.y = pk_bf16(p[2], p[3]); pp.z = pk_bf16(p[4], p[5]); pp.w = pk_bf16(p[6], p[7]);
                pf[k2][n2] = __builtin_bit_cast(bf16x8, pp); }
        }
    }
    f32x4 o[8][2];
#pragma unroll
    for (int mt = 0; mt < 8; ++mt)
#pragma unroll
        for (int n2 = 0; n2 < 2; ++n2) o[mt][n2] = (f32x4){0.f, 0.f, 0.f, 0.f};
#pragma unroll
    for (int mt = 0; mt < 8; ++mt)
#pragma unroll
        for (int k2 = 0; k2 < 8; ++k2) { const LAS unsigned char* vp = Vl + (16 * mt + l15) * 528 + (32 * k2 + 4 * g) * 2;
            const u32x2 lo = *(const LAS u32x2*)vp, hi = *(const LAS u32x2*)(vp + 32);
            const bf16x8 a = __builtin_bit_cast(bf16x8, (u32x4){lo.x, lo.y, hi.x, hi.y});
#pragma unroll
            for (int n2 = 0; n2 < 2; ++n2) o[mt][n2] = __builtin_amdgcn_mfma_f32_16x16x32_bf16(a, pf[k2][n2], o[mt][n2], 0, 0, 0); }
    __syncthreads();
    { const bf16_t* kv = F.KV + (size_t)it * 32768;
#pragma unroll
      for (int p = 0; p < 8; ++p) { const int idx = p * NTHR + tid, row = idx >> 4, c = idx & 15;
          *(LAS u32x4*)(Kl + row * 272 + c * 16) = *(const u32x4*)(kv + (size_t)idx * 8); } }
    __syncthreads();
    {
        float qfd[2], qbd[2];
#pragma unroll
        for (int n2 = 0; n2 < 2; ++n2) { const int i = 32 * w + 16 * n2 + l15; qfd[n2] = __builtin_amdgcn_exp2f(lg2f * (float)(i + 1)); qbd[n2] = __builtin_amdgcn_exp2f(lg2b * (float)(256 - i)); }
#pragma unroll
        for (int mt = 0; mt < 8; ++mt) {
            f32x4 tf[2], tb[2];
#pragma unroll
            for (int n2 = 0; n2 < 2; ++n2) { tf[n2] = (f32x4){0.f, 0.f, 0.f, 0.f}; tb[n2] = (f32x4){0.f, 0.f, 0.f, 0.f}; }
#pragma unroll
            for (int kk = 0; kk < 4; ++kk) { const LAS unsigned char* sp = Kl + (16 * mt + l15) * 272 + (32 * kk + 8 * g) * 2;
                const bf16x8 af = *(const LAS bf16x8*)sp, ab = *(const LAS bf16x8*)(sp + 34816);
#pragma unroll
                for (int n2 = 0; n2 < 2; ++n2) { tf[n2] = __builtin_amdgcn_mfma_f32_16x16x32_bf16(af, qf[n2][kk], tf[n2], 0, 0, 0); tb[n2] = __builtin_amdgcn_mfma_f32_16x16x32_bf16(ab, qf[n2][kk], tb[n2], 0, 0, 0); } }
#pragma unroll
            for (int n2 = 0; n2 < 2; ++n2) o[mt][n2] += tf[n2] * qfd[n2] + tb[n2] * qbd[n2];
        }
    }
#pragma unroll
    for (int n2 = 0; n2 < 2; ++n2) {
        float s1 = 0.f;
#pragma unroll
        for (int mt = 0; mt < 8; ++mt) s1 += (o[mt][n2][0] + o[mt][n2][1]) + (o[mt][n2][2] + o[mt][n2][3]);
        s1 += __shfl_xor(s1, 16); s1 += __shfl_xor(s1, 32);
        const float mu = s1 * (1.0f / 128.0f); float s2 = 0.f;
#pragma unroll
        for (int mt = 0; mt < 8; ++mt) { const f32x4 d = o[mt][n2] - mu; s2 += (d[0] * d[0] + d[1] * d[1]) + (d[2] * d[2] + d[3] * d[3]); }
        s2 += __shfl_xor(s2, 16); s2 += __shfl_xor(s2, 32);
        const float rs = rsqrtf(s2 * (1.0f / 128.0f) + EPS);
        bf16_t* zp = F.Z + (size_t)(R.m0 + 32 * w + 16 * n2 + l15) * DMIX + 1024 + R.h * 128 + 4 * g;
#pragma unroll
        for (int mt = 0; mt < 8; ++mt) { const u32x2 z = *(const u32x2*)(zp + 16 * mt); const f32x4 d = (o[mt][n2] - mu) * rs;
            u32x2 ov; ov.x = pk_bf16(d[0] * bf_lo(z.x), d[1] * bf_hi(z.x)); ov.y = pk_bf16(d[2] * bf_lo(z.y), d[3] * bf_hi(z.y));
            if (DUMMY) *(u32x2*)(F.U + (size_t)(R.m0 + 32 * w + 16 * n2 + l15) * DM + R.h * 128 + 4 * g + 16 * mt) = ov; else *(u32x2*)(zp + 16 * mt) = ov; }
    }
    __syncthreads();
}

struct SchedOut {
    const char* Y; const char* W; int G, c;
    __device__ __forceinline__ bool next(int i, pg8::Unit& u) const {
        int pm, pn; if (!pg8::order_next(i, G, c, T_ALL / 256, DM / 256, pm, pn)) return false;
        const size_t tstep = (size_t)256 * DMIX * 2; u.a = Y + (size_t)pm * tstep; u.b = W + (size_t)pn * tstep; u.pm = pm; u.pn = pn; return true;
    }
};
struct EpiOut {
    bf16_t* O; float* part;
    __device__ __forceinline__ void operator()(const f32x4 (&acc)[2][2][4][2], const pg8::Unit& u, int wr, int wc, int fr, int fq) const {
#pragma unroll
        for (int ai = 0; ai < 2; ++ai)
#pragma unroll
            for (int m = 0; m < 4; ++m) { const size_t row = (size_t)(u.pm * 256 + ai * 128 + wr * 64 + m * 16 + fr); bf16_t* rp = O + row * DM + u.pn * 256 + wc * 32 + 8 * fq; float ss = 0.f;
#pragma unroll
                for (int bj = 0; bj < 2; ++bj) { const f32x4 v0 = acc[ai][bj][m][0], v1 = acc[ai][bj][m][1];
                    ss += (v0[0] * v0[0] + v0[1] * v0[1]) + (v0[2] * v0[2] + v0[3] * v0[3]) + (v1[0] * v1[0] + v1[1] * v1[1]) + (v1[2] * v1[2] + v1[3] * v1[3]);
                    u32x4 w; w.x = pk_bf16(v0[0], v0[1]); w.y = pk_bf16(v0[2], v0[3]); w.z = pk_bf16(v1[0], v1[1]); w.w = pk_bf16(v1[2], v1[3]);
                    *(u32x4*)(rp + bj * 128) = w; }
                ss += __shfl_xor(ss, 16); ss += __shfl_xor(ss, 32);
                if (fq == 0) part[row * 16 + u.pn * 4 + wc] = ss; }
    }
};

__device__ __forceinline__ void p7_final(const Ctx& F) {
    const int gw = F.bid * NWAVES + F.wave, NGW = F.G * NWAVES;
    for (int gi = gw; gi < T_ALL / 16; gi += NGW) {
        const int m0 = gi * 16; int b16, pos; row_info(m0, b16, pos);
        const float* md = F.mod + b16 * 3072 + 2048;
        f32x4 gg[4];
#pragma unroll
        for (int j = 0; j < 4; ++j) { const int c = 4 * F.lane + 256 * j; gg[j] = *(const f32x4*)(F.g_post + c) * *(const f32x4*)(md + c); }
        for (int r = 0; r < 16; ++r) {
            const int m = m0 + r;
            float ss = F.part[(size_t)m * 16 + (F.lane & 15)];
            ss += __shfl_xor(ss, 1); ss += __shfl_xor(ss, 2); ss += __shfl_xor(ss, 4); ss += __shfl_xor(ss, 8);
            const float rstd = rsqrtf(ss * (1.f / DM) + EPS);
            const f32x4* xr = (const f32x4*)x_row(F, m) + F.lane;
            const u32x2* orow = (const u32x2*)(F.OUTB + (size_t)m * DM) + F.lane;
            f32x4* dst = (f32x4*)(F.out + (size_t)m * DM) + F.lane;
#pragma unroll
            for (int j = 0; j < 4; ++j) { const u32x2 ov = orow[64 * j]; const f32x4 xv = xr[64 * j];
                f32x4 y; y.x = xv.x + gg[j].x * (bf_lo(ov.x) * rstd); y.y = xv.y + gg[j].y * (bf_hi(ov.x) * rstd); y.z = xv.z + gg[j].z * (bf_lo(ov.y) * rstd); y.w = xv.w + gg[j].w * (bf_hi(ov.y) * rstd);
                dst[64 * j] = y; }
        }
    }
}

__global__ void __launch_bounds__(NTHR, 2) fwd_megakernel(Args args) {
    extern __shared__ __attribute__((aligned(16))) unsigned char smem[];
    cg::grid_group grid = cg::this_grid();
    LAS unsigned char* lds = (LAS unsigned char*)smem;
    Ctx F;
    F.xp = args.in[0]; F.xs = args.in[1]; F.cp = args.in[2]; F.cs = args.in[3]; F.ada_w = args.in[4]; F.ada_b = args.in[5]; F.g_pre = args.in[6]; F.g_post = args.in[7];
    F.w_in = args.in[8]; F.pool_w = args.in[9]; F.pool_scale = args.in[10]; F.dec_f = args.in[11]; F.dec_b = args.in[12]; F.w_out = args.in[13];
    F.out = args.out; F.ws = args.ws;
    F.mod = (float*)(args.ws + WS_MOD); F.WinT = (bf16_t*)(args.ws + WS_WIN); F.WoutT = (bf16_t*)(args.ws + WS_WOUT); F.part = (float*)(args.ws + WS_PART);
    F.H = (bf16_t*)(args.ws + WS_H); F.U = (bf16_t*)(args.ws + WS_U); F.Q = (bf16_t*)(args.ws + WS_Q); F.Kb = (bf16_t*)(args.ws + WS_K); F.VT = (bf16_t*)(args.ws + WS_VT);
    F.Z = (bf16_t*)args.out; F.KV = (bf16_t*)(args.ws + WS_H); F.OUTB = (bf16_t*)(args.ws + WS_U);
    F.tid = threadIdx.x; F.lane = F.tid & 63; F.wave = __builtin_amdgcn_readfirstlane(F.tid >> 6); F.G = gridDim.x; F.bid = blockIdx.x;
    const int lo = args.ph_lo, hi = args.ph_hi;
#define IN(k) (lo <= (k) && (k) < hi)
#define SEAM(k) do { if (IN(k) && IN((k) + 1)) grid.sync(); } while (0)
    if (IN(0)) { p0_prologue(F, lds); } SEAM(0);
    if (IN(1)) { p1_prenorm(F); } SEAM(1);
#ifndef PROBE_DUP
#define PROBE_DUP 0
#endif
    if (IN(2)) { for (int rep = 0; rep < (PROBE_DUP == 2 ? 2 : 1); ++rep) { SchedIn S{(const char*)F.H, (const char*)F.WinT, F.G, F.bid}; EpiIn E{F.U, F.Q, F.Kb, F.VT, F.Z}; pg8::gemm_phase<EpiIn, SchedIn>(lds, DM, S, E); } } SEAM(2);
    if (IN(3)) {
        if (F.bid & 1) for (int pt = F.bid; pt < T_ALL / 64; pt += F.G) pool_item(F, pt);
        for (int rep = 0; rep < (PROBE_DUP == 3 ? 2 : 1); ++rep) for (int it = F.bid; it < 3072; it += F.G) ra_item(F, it, lds);
        if (!(F.bid & 1)) for (int pt = F.bid; pt < T_ALL / 64; pt += F.G) pool_item(F, pt);
    } SEAM(3);
    if (IN(4)) { rb_scan(F); } SEAM(4);
    if (IN(5)) { if (PROBE_DUP == 5) for (int it = F.bid; it < 3072; it += F.G) rc_item<true>(F, it, lds);
                 for (int it = F.bid; it < 3072; it += F.G) rc_item<false>(F, it, lds); } SEAM(5);
    if (IN(6)) { for (int rep = 0; rep < (PROBE_DUP == 6 ? 2 : 1); ++rep) { SchedOut S{(const char*)F.Z, (const char*)F.WoutT, F.G, F.bid}; EpiOut E{F.OUTB, F.part}; pg8::gemm_phase<EpiOut, SchedOut>(lds, DMIX, S, E); } } SEAM(6);
    if (IN(7)) { p7_final(F); }
}

#ifndef N_LAUNCH_MODE
#define N_LAUNCH_MODE 1
#endif

extern "C" void kernel_launch(void* const* d_in, const int* in_sizes, int n_in, void* d_out, int out_size, void* d_ws, size_t ws_size, hipStream_t stream) {
    static int grid = 0;
    if (grid == 0) {
        if (n_in != 14 || out_size != T_ALL * DM || ws_size < WS_END) { fprintf(stderr, "kernel_launch: unexpected shapes (n_in %d out %d ws %zu)\n", n_in, out_size, ws_size); grid = -1; return; }
        int dev = 0, cus = 0, per_cu = 0;
        hipGetDevice(&dev); hipDeviceGetAttribute(&cus, hipDeviceAttributeMultiprocessorCount, dev);
        if (hipFuncSetAttribute((const void*)fwd_megakernel, hipFuncAttributeMaxDynamicSharedMemorySize, LDS_BYTES) != hipSuccess) { fprintf(stderr, "kernel_launch: hipFuncSetAttribute failed\n"); grid = -1; return; }
        if (hipOccupancyMaxActiveBlocksPerMultiprocessor(&per_cu, (const void*)fwd_megakernel, NTHR, LDS_BYTES) != hipSuccess || per_cu < 1) { fprintf(stderr, "kernel_launch: occupancy query says %d\n", per_cu); per_cu = 1; }
        (void)hipGetLastError();
        grid = cus * per_cu;
        fprintf(stderr, "kernel_launch: cus %d per_cu %d grid %d\n", cus, per_cu, grid);
    }
    if (grid < 0) return;
    Args a{};
    for (int i = 0; i < 14; ++i) a.in[i] = (const float*)d_in[i];
    a.out = (float*)d_out; a.ws = (unsigned char*)d_ws;
#if N_LAUNCH_MODE == 1
    a.ph_lo = 0; a.ph_hi = 8;
    void* kargs[] = {&a};
    hipError_t e = hipLaunchCooperativeKernel((const void*)fwd_megakernel, dim3(grid), dim3(NTHR), kargs, LDS_BYTES, stream);
    if (e != hipSuccess) fprintf(stderr, "kernel_launch: cooperative launch failed: %s (grid %d)\n", hipGetErrorString(e), grid);
#else
    for (int p = 0; p < 8; ++p) { a.ph_lo = p; a.ph_hi = p + 1; hipLaunchKernelGGL(fwd_megakernel, dim3(grid), dim3(NTHR), LDS_BYTES, stream, a); }
#endif
}
```

```cpp
#include <hip/hip_runtime.h>
#include <hip/hip_cooperative_groups.h>
#include <cstdio>
#include <cstdint>
namespace cg = cooperative_groups;

#define LAS __attribute__((address_space(3)))
typedef unsigned short bf16_t;
typedef short bf16x8 __attribute__((ext_vector_type(8)));
typedef float f32x4 __attribute__((ext_vector_type(4)));
typedef unsigned u32x4 __attribute__((ext_vector_type(4)));
typedef unsigned u32x2 __attribute__((ext_vector_type(2)));

constexpr int NTHR = 512, NWAVES = 8;
constexpr int DM = 1024, DIN = 6144, DMIX = 2048;
constexpr int T_P = 65536, T_S = 32768, T_ALL = 98304, S_P = 8192, S_S = 4096;
constexpr float EPS = 1e-6f;
constexpr size_t MiB = 1u << 20;
constexpr size_t WS_MOD = 0;
constexpr size_t WS_WIN = 1 * MiB;
constexpr size_t WS_WOUT = 13 * MiB;
constexpr size_t WS_PART = 17 * MiB;
constexpr size_t WS_H = 24 * MiB;
constexpr size_t WS_U = 216 * MiB;
constexpr size_t WS_Q = 408 * MiB;
constexpr size_t WS_K = 600 * MiB;
constexpr size_t WS_VT = 792 * MiB;
constexpr size_t WS_END = 984 * MiB;
constexpr int LDS_BYTES = 147456;

__device__ __forceinline__ unsigned pk_bf16(float lo, float hi) { unsigned r; asm("v_cvt_pk_bf16_f32 %0, %1, %2" : "=v"(r) : "v"(lo), "v"(hi)); return r; }
__device__ __forceinline__ float bf_lo(unsigned u) { return __uint_as_float(u << 16); }
__device__ __forceinline__ float bf_hi(unsigned u) { return __uint_as_float(u & 0xffff0000u); }
__device__ __forceinline__ float wave_sum(float v) {
#pragma unroll
    for (int o = 1; o < 64; o <<= 1) v += __shfl_xor(v, o);
    return v;
}
__device__ __forceinline__ float silu_f(float z) { return z * __builtin_amdgcn_rcpf(1.0f + __builtin_amdgcn_exp2f(-1.4426950408889634f * z)); }
__device__ __forceinline__ void row_info(int m, int& b16, int& pos) { if (m < T_P) { b16 = m >> 13; pos = m & 8191; } else { const int mm = m - T_P; b16 = 8 + (mm >> 12); pos = mm & 4095; } }

namespace pg8 {
constexpr int BM = 256, BK = 64, HALF = 128, HTB = HALF * BK * 2, STAGE_BYTES = 8 * HTB, NXCD = 8, WGM = 8;
__host__ __device__ __forceinline__ int lds_byte(int r, int c) { const int st = (r >> 4) * 2 + (c >> 5), rr = r & 15, cc = c & 31, ob = rr * 64 + cc * 2; return st * 1024 + (ob ^ (((ob >> 9) & 1) << 5)); }
__host__ __device__ __forceinline__ void stage_rc(int b, int& R, int& C) { const int st = b / 1024, sb = b % 1024, swz = sb ^ (((sb >> 9) & 1) << 5); R = (st >> 1) * 16 + swz / 64; C = (st & 1) * 32 + (swz % 64) / 2; }
__host__ __device__ __forceinline__ int perm32(int rho) { const int n = rho >> 4, i = rho & 15; return 8 * (i >> 2) + 4 * n + (i & 3); }

struct Unit { const char* a; const char* b; int pm, pn; };

__device__ __forceinline__ bool order_next(int i, int G, int c, int nM, int nN, int& pm, int& pn) {
    const int nwg = nM * nN; const long L = (long)i * G + c; if (L >= nwg) return false;
    int wgid = (int)L; { const int q = nwg / NXCD, r = nwg % NXCD, xcd = wgid % NXCD, off = wgid / NXCD; wgid = (xcd < r ? xcd * (q + 1) : r * (q + 1) + (xcd - r) * q) + off; }
    const int nig = WGM * nN, gid = wgid / nig, fm = gid * WGM, gsz = (nM - fm) < WGM ? (nM - fm) : WGM;
    pm = fm + ((wgid % nig) % gsz); pn = (wgid % nig) / gsz; return true;
}

template <class Epi, class Sched>
__device__ __forceinline__ void gemm_phase(LAS unsigned char* lds, const int K, const Sched& S, const Epi& E) {
    const int tid = threadIdx.x, wid = __builtin_amdgcn_readfirstlane(tid >> 6), lane = tid & 63, wr = wid >> 2, wc = wid & 3, fr = lane & 15, fq = lane >> 4;
    const int nt = K / BK;
    unsigned voffA[2], voffB[2];
#pragma unroll
    for (int i = 0; i < 2; ++i) { int R, C; stage_rc(tid * 16 + i * 8192, R, C); const int Rb = (R & ~31) + perm32(R & 31);
        voffA[i] = (unsigned)(R * K + C) * 2u; voffB[i] = (unsigned)(Rb * K + C) * 2u; }
    const size_t kstep = (size_t)(BK * 2);
    const size_t hstep = (size_t)HALF * K * 2;
    const unsigned ldsw = (unsigned)wid * 1024u;
    const int aoff = lds_byte(wr * 64 + fr, fq * 8), boff = lds_byte(wc * 32 + fr, fq * 8);
#define PG8_SA(b, h) (((b) * 2 + (h)) * HTB)
#define PG8_SB(b, h) ((4 + (b) * 2 + (h)) * HTB)
#define PG8_STAGE(bufoff, gbase, voff) do { _Pragma("unroll") for (int _i = 0; _i < 2; ++_i) \
        __builtin_amdgcn_global_load_lds((const unsigned*)((const char*)(gbase) + (voff)[_i]), (LAS unsigned*)(lds + (bufoff) + ldsw + _i * 8192), 16, 0, 0); } while (0)
#define PG8_LDA(dst, b, h) do { _Pragma("unroll") for (int m = 0; m < 4; ++m) _Pragma("unroll") for (int k = 0; k < 2; ++k) dst[m][k] = *(const LAS bf16x8*)(lds + PG8_SA(b, h) + aoff + m * 2048 + k * 1024); } while (0)
#define PG8_LDB(dst, b, h) do { _Pragma("unroll") for (int n = 0; n < 2; ++n) _Pragma("unroll") for (int k = 0; k < 2; ++k) dst[n][k] = *(const LAS bf16x8*)(lds + PG8_SB(b, h) + boff + n * 2048 + k * 1024); } while (0)
#define PG8_MMA(ai, bj, At, Bt) do { __builtin_amdgcn_s_setprio(1); _Pragma("unroll") for (int m = 0; m < 4; ++m) _Pragma("unroll") for (int n = 0; n < 2; ++n) _Pragma("unroll") for (int k = 0; k < 2; ++k) \
        acc[ai][bj][m][n] = __builtin_amdgcn_mfma_f32_16x16x32_bf16(Bt[n][k], At[m][k], acc[ai][bj][m][n], 0, 0, 0); __builtin_amdgcn_s_setprio(0); } while (0)
#define PG8_WAIT_V(n) asm volatile("s_waitcnt vmcnt(" #n ")" ::: "memory")
#define PG8_WAIT_L(n) asm volatile("s_waitcnt lgkmcnt(" #n ")" ::: "memory")
#define PG8_BAR __builtin_amdgcn_s_barrier()
#define PG8_SCHED __builtin_amdgcn_sched_barrier(0)
    Unit cur, nxt; int ui = 0;
    if (!S.next(0, cur)) return;
    f32x4 acc[2][2][4][2];
#pragma unroll
    for (int a = 0; a < 2; ++a)
#pragma unroll
        for (int b = 0; b < 2; ++b)
#pragma unroll
            for (int m = 0; m < 4; ++m)
#pragma unroll
                for (int n = 0; n < 2; ++n) acc[a][b][m][n] = (f32x4){0.f, 0.f, 0.f, 0.f};
    bf16x8 At[4][2], B0[2][2], B1[2][2];
    const char* cA = cur.a; const char* cB = cur.b;
    PG8_STAGE(PG8_SB(0, 0), cB, voffB); PG8_STAGE(PG8_SB(0, 1), cB + hstep, voffB); PG8_STAGE(PG8_SA(0, 0), cA, voffA); PG8_STAGE(PG8_SA(0, 1), cA + hstep, voffA);
    if (wr == 1) PG8_BAR;
    PG8_WAIT_V(2); PG8_BAR;
    PG8_STAGE(PG8_SB(1, 0), cB + kstep, voffB); PG8_STAGE(PG8_SA(1, 0), cA + kstep, voffA); PG8_STAGE(PG8_SB(1, 1), cB + hstep + kstep, voffB);
    PG8_WAIT_V(6); PG8_BAR;
    for (;;) {
        const bool has_next = S.next(ui + 1, nxt);
        const char* nA = has_next ? nxt.a : cA; const char* nB = has_next ? nxt.b : cB;
        for (int t = 0; t < nt; t += 2) {
            const bool last = (t == nt - 2);
            const char* a1 = cA + (size_t)(t + 1) * kstep;
            const char* a2 = last ? nA : cA + (size_t)(t + 2) * kstep; const char* b2 = last ? nB : cB + (size_t)(t + 2) * kstep;
            const char* a3 = a2 + kstep; const char* b3 = b2 + kstep;
            PG8_LDB(B0, 0, 0); PG8_LDB(B1, 0, 1); PG8_SCHED; PG8_LDA(At, 0, 0); PG8_STAGE(PG8_SA(1, 1), a1 + hstep, voffA);
            PG8_WAIT_V(8); PG8_WAIT_L(0); PG8_BAR; PG8_MMA(0, 0, At, B0); PG8_MMA(0, 1, At, B1); PG8_BAR; PG8_SCHED;
            PG8_LDA(At, 0, 1); PG8_STAGE(PG8_SB(0, 0), b2, voffB); PG8_STAGE(PG8_SB(0, 1), b2 + hstep, voffB); PG8_STAGE(PG8_SA(0, 0), a2, voffA);
            PG8_WAIT_V(8); PG8_WAIT_L(0); PG8_BAR; PG8_MMA(1, 0, At, B0); PG8_MMA(1, 1, At, B1); PG8_BAR; PG8_SCHED;
            PG8_LDB(B0, 1, 0); PG8_LDB(B1, 1, 1); PG8_SCHED; PG8_LDA(At, 1, 0); PG8_STAGE(PG8_SA(0, 1), a2 + hstep, voffA);
            PG8_WAIT_V(8); PG8_WAIT_L(0); PG8_BAR; PG8_MMA(0, 0, At, B0); PG8_MMA(0, 1, At, B1); PG8_BAR; PG8_SCHED;
            PG8_LDA(At, 1, 1); PG8_STAGE(PG8_SB(1, 0), b3, voffB); PG8_STAGE(PG8_SB(1, 1), b3 + hstep, voffB); PG8_STAGE(PG8_SA(1, 0), a3, voffA);
            PG8_WAIT_V(8); PG8_WAIT_L(0); PG8_BAR; PG8_MMA(1, 0, At, B0); PG8_MMA(1, 1, At, B1); PG8_BAR; PG8_SCHED;
        }
        if (wr == 0) PG8_BAR;
        E(acc, cur, wr, wc, fr, fq);
        if (!has_next) break;
#pragma unroll
        for (int a = 0; a < 2; ++a)
#pragma unroll
            for (int b = 0; b < 2; ++b)
#pragma unroll
                for (int m = 0; m < 4; ++m)
#pragma unroll
                    for (int n = 0; n < 2; ++n) acc[a][b][m][n] = (f32x4){0.f, 0.f, 0.f, 0.f};
        cur = nxt; cA = nA; cB = nB; ++ui;
        if (wr == 1) PG8_BAR;
    }
    PG8_WAIT_V(0);
    PG8_BAR;
#undef PG8_SA
#undef PG8_SB
#undef PG8_STAGE
#undef PG8_LDA
#undef PG8_LDB
#undef PG8_MMA
#undef PG8_WAIT_V
#undef PG8_WAIT_L
#undef PG8_BAR
#undef PG8_SCHED
}
}

struct Args { const float* in[14]; float* out; unsigned char* ws; int ph_lo, ph_hi; };

struct Ctx {
    const float *xp, *xs, *cp, *cs, *ada_w, *ada_b, *g_pre, *g_post, *w_in, *pool_w, *pool_scale, *dec_f, *dec_b, *w_out;
    float* out; unsigned char* ws;
    float* mod; bf16_t *WinT, *WoutT; float* part; bf16_t *H, *U, *Q, *Kb, *VT, *Z, *KV, *OUTB;
    int tid, lane, wave, G, bid;
};
__device__ __forceinline__ const float* x_row(const Ctx& F, int m) { return m < T_P ? F.xp + (size_t)m * DM : F.xs + (size_t)(m - T_P) * DM; }

__device__ __forceinline__ int colmap(int rho) {
    const int pn = rho >> 8;
    if (pn < 4 || pn >= 12) return rho;
    const int s = rho & 255, bj = s >> 7, sp = s & 127;
    return 1024 * (pn >> 2) + (2 * (pn & 3) + (sp >> 6)) * 128 + 64 * bj + (sp & 63);
}
__device__ __forceinline__ void p0_write_tile(bf16_t* WT, int Kdst, int row0, int k0, LAS float* scr, int lane) {
    asm volatile("s_waitcnt lgkmcnt(0)" ::: "memory");
    const int c = lane & 7;
#pragma unroll
    for (int j = 0; j < 4; ++j) { const int n = (lane >> 3) + 8 * j; const LAS float* s = scr + (8 * c) * 33 + n;
        u32x4 o; o.x = pk_bf16(s[0 * 33], s[1 * 33]); o.y = pk_bf16(s[2 * 33], s[3 * 33]); o.z = pk_bf16(s[4 * 33], s[5 * 33]); o.w = pk_bf16(s[6 * 33], s[7 * 33]);
        *(u32x4*)(WT + (size_t)(row0 + n) * Kdst + k0 + 8 * c) = o; }
    asm volatile("s_waitcnt lgkmcnt(0)" ::: "memory");
}
__device__ __forceinline__ void p0_transpose_item(const float* W, int N, int k0, int n0src, bf16_t* WT, int Kdst, int row0, LAS float* scr, int lane) {
#pragma unroll 8
    for (int i = 0; i < 32; ++i) { const int kk = 2 * i + (lane >> 5); scr[kk * 33 + (lane & 31)] = W[(size_t)(k0 + kk) * N + n0src + (lane & 31)]; }
    p0_write_tile(WT, Kdst, row0, k0, scr, lane);
}
__device__ __forceinline__ void p0_fold_item(const Ctx& F, int item, LAS float* scr, int lane) {
    const int kb = item >> 5, nb = item & 31, k0 = 64 * kb, rho0 = 32 * nb, g = rho0 >> 8, d0 = rho0 & 255;
    const int kl = lane >> 3, dg = lane & 7;
    f32x4 acc[8];
#pragma unroll
    for (int q = 0; q < 8; ++q) acc[q] = (f32x4){0.f, 0.f, 0.f, 0.f};
    const float* pw0 = F.pool_w + (size_t)g * 65536 + d0 + 4 * dg;
    const float* wi0 = F.w_in + (size_t)(k0 + kl) * DIN + g * 256;
    for (int c = 0; c < 256; c += 4) {
        f32x4 pw[4];
#pragma unroll
        for (int cc = 0; cc < 4; ++cc) pw[cc] = *(const f32x4*)(pw0 + (size_t)(c + cc) * 256);
#pragma unroll
        for (int q = 0; q < 8; ++q) { const f32x4 wv = *(const f32x4*)(wi0 + (size_t)(8 * q) * DIN + c);
            acc[q] += wv.x * pw[0] + wv.y * pw[1] + wv.z * pw[2] + wv.w * pw[3]; }
    }
#pragma unroll
    for (int q = 0; q < 8; ++q)
#pragma unroll
        for (int e = 0; e < 4; ++e) scr[(kl + 8 * q) * 33 + 4 * dg + e] = acc[q][e];
    p0_write_tile(F.WinT, DM, rho0, k0, scr, lane);
}
__device__ __forceinline__ void p0_prologue(const Ctx& F, LAS unsigned char* lds) {
    LAS float* scr = (LAS float*)(lds + F.wave * 16384);
    if (F.bid < 48) {
        LAS float* sv = scr; LAS float* red = (LAS float*)(lds + F.wave * 16384 + 12288);
        const int kw0 = 128 * F.wave;
        for (int idx = F.lane; idx < 2048; idx += 64) { const int r = idx >> 7, kk = idx & 127;
            const float c = r < 8 ? F.cp[r * DM + kw0 + kk] : F.cs[(r - 8) * DM + kw0 + kk]; sv[idx] = silu_f(c); }
        asm volatile("s_waitcnt lgkmcnt(0)" ::: "memory");
        float a16[16];
#pragma unroll
        for (int r = 0; r < 16; ++r) a16[r] = 0.f;
        const float* wp = F.ada_w + (size_t)kw0 * 3072 + 64 * F.bid + F.lane;
        for (int kk = 0; kk < 128; ++kk) { const float wv = wp[(size_t)kk * 3072];
#pragma unroll
            for (int r = 0; r < 16; ++r) a16[r] += sv[r * 128 + kk] * wv; }
#pragma unroll
        for (int r = 0; r < 16; ++r) red[r * 64 + F.lane] = a16[r];
        __syncthreads();
        for (int o = F.tid; o < 1024; o += NTHR) { const int r = o >> 6, col = o & 63; float s = F.ada_b[64 * F.bid + col];
#pragma unroll
            for (int w = 0; w < 8; ++w) s += *((LAS float*)(lds + w * 16384 + 12288) + r * 64 + col);
            F.mod[r * 3072 + 64 * F.bid + col] = s; }
    }
    const int gw = F.bid * NWAVES + F.wave, NGW = F.G * NWAVES;
    constexpr int I_FOLD = 512, I_IN = 16 * 160, I_OUT = 32 * 32;
    for (int it = gw; it < I_FOLD + I_IN + I_OUT; it += NGW) {
        int r = it;
        if (r < I_FOLD) { p0_fold_item(F, r, scr, F.lane); continue; } r -= I_FOLD;
        if (r < I_IN) { const int kb = r / 160, nb = r % 160, rho0 = 1024 + 32 * nb; p0_transpose_item(F.w_in, DIN, 64 * kb, colmap(rho0), F.WinT, DM, rho0, scr, F.lane); continue; } r -= I_IN;
        { const int kb = r >> 5, nb = r & 31; p0_transpose_item(F.w_out, DM, 64 * kb, 32 * nb, F.WoutT, DMIX, 32 * nb, scr, F.lane); }
    }
}

__device__ __forceinline__ void p1_prenorm(const Ctx& F) {
    const int gw = F.bid * NWAVES + F.wave, NGW = F.G * NWAVES;
    for (int gi = gw; gi < T_ALL / 16; gi += NGW) {
        const int m0 = gi * 16; int b16, pos; row_info(m0, b16, pos);
        const float* md = F.mod + b16 * 3072;
        f32x4 ga[4], sh[4];
#pragma unroll
        for (int j = 0; j < 4; ++j) { const int c = 4 * F.lane + 256 * j; const f32x4 g = *(const f32x4*)(F.g_pre + c), sc = *(const f32x4*)(md + 1024 + c);
            ga[j] = g * (sc + 1.0f); sh[j] = *(const f32x4*)(md + c); }
        for (int r = 0; r < 16; ++r) {
            const f32x4* xr = (const f32x4*)x_row(F, m0 + r) + F.lane;
            f32x4 v[4]; float s = 0.f;
#pragma unroll
            for (int j = 0; j < 4; ++j) { v[j] = xr[64 * j]; s += (v[j].x * v[j].x + v[j].y * v[j].y) + (v[j].z * v[j].z + v[j].w * v[j].w); }
            const float rstd = rsqrtf(wave_sum(s) * (1.f / DM) + EPS);
            u32x2* o8 = (u32x2*)(F.H + (size_t)(m0 + r) * DM) + F.lane;
#pragma unroll
            for (int j = 0; j < 4; ++j) { const f32x4 y = v[j] * rstd * ga[j] + sh[j]; u32x2 w; w.x = pk_bf16(y.x, y.y); w.y = pk_bf16(y.z, y.w); o8[64 * j] = w; }
        }
    }
}

struct SchedIn {
    const char* H; const char* W; int G, c;
    __device__ __forceinline__ bool next(int i, pg8::Unit& u) const {
        int pm, pn; if (!pg8::order_next(i, G, c, T_ALL / 256, DIN / 256, pm, pn)) return false;
        const size_t tstep = (size_t)256 * DM * 2; const char* hp = H + (size_t)pm * tstep; const char* wp = W + (size_t)pn * tstep;
        const bool sw = (pn >= 12 && pn < 16);
        u.a = sw ? wp : hp; u.b = sw ? hp : wp; u.pm = pm; u.pn = pn; return true;
    }
};
struct EpiIn {
    bf16_t *U, *Q, *Kb, *VT, *Z;
    __device__ __forceinline__ void operator()(const f32x4 (&acc)[2][2][4][2], const pg8::Unit& u, int wr, int wc, int fr, int fq) const {
        const int pm = u.pm, pn = u.pn;
        if (pn < 4) {
#pragma unroll
            for (int ai = 0; ai < 2; ++ai)
#pragma unroll
                for (int m = 0; m < 4; ++m) { bf16_t* rp = U + (size_t)(pm * 256 + ai * 128 + wr * 64 + m * 16 + fr) * DM + pn * 256 + wc * 32 + 8 * fq;
#pragma unroll
                    for (int bj = 0; bj < 2; ++bj) { const f32x4 v0 = acc[ai][bj][m][0], v1 = acc[ai][bj][m][1];
                        u32x4 w; w.x = pk_bf16(v0[0], v0[1]); w.y = pk_bf16(v0[2], v0[3]); w.z = pk_bf16(v1[0], v1[1]); w.w = pk_bf16(v1[2], v1[3]);
                        *(u32x4*)(rp + bj * 128) = w; } }
        } else if (pn < 12) {
            const bool isk = pn >= 8; bf16_t* base = isk ? Kb : Q; const float scl = isk ? 0.08838834764831845f : 1.0f;
            const int head = 2 * (pn & 3) + (wc >> 1), dlo = 32 * (wc & 1) + 8 * fq;
            const int pos0 = pm < 256 ? (pm & 31) * 256 : ((pm - 256) & 15) * 256;
            float cf[8];
#pragma unroll
            for (int e = 0; e < 8; ++e) cf[e] = __builtin_amdgcn_exp2f(-(float)(dlo + e) * 0.20762050593046014f) * 0.15915494309189535f;
#pragma unroll
            for (int ai = 0; ai < 2; ++ai)
#pragma unroll
                for (int m = 0; m < 4; ++m) {
                    const int rl = ai * 128 + wr * 64 + m * 16 + fr; const float fpos = (float)(pos0 + rl);
                    float o1[8], o2[8];
#pragma unroll
                    for (int e = 0; e < 8; ++e) {
                        const float rev = fpos * cf[e]; const float fr_ = __builtin_amdgcn_fractf(rev);
                        const float sn = __builtin_amdgcn_sinf(fr_), cs = __builtin_amdgcn_cosf(fr_);
                        const float x1 = acc[ai][0][m][e >> 2][e & 3], x2 = acc[ai][1][m][e >> 2][e & 3];
                        o1[e] = (x1 * cs - x2 * sn) * scl; o2[e] = (x2 * cs + x1 * sn) * scl;
                    }
                    bf16_t* rp = base + (size_t)(pm * 256 + rl) * DM + head * 128 + dlo;
                    u32x4 w1, w2; w1.x = pk_bf16(o1[0], o1[1]); w1.y = pk_bf16(o1[2], o1[3]); w1.z = pk_bf16(o1[4], o1[5]); w1.w = pk_bf16(o1[6], o1[7]);
                    w2.x = pk_bf16(o2[0], o2[1]); w2.y = pk_bf16(o2[2], o2[3]); w2.z = pk_bf16(o2[4], o2[5]); w2.w = pk_bf16(o2[6], o2[7]);
                    *(u32x4*)rp = w1; *(u32x4*)(rp + 64) = w2;
                }
        } else if (pn < 16) {
            int b, t0, S; size_t gbase;
            if (pm < 256) { b = pm >> 5; t0 = (pm & 31) * 256; S = S_P; gbase = 0; } else { const int q = pm - 256; b = q >> 4; t0 = (q & 15) * 256; S = S_S; gbase = (size_t)64 * 128 * S_P; }
#pragma unroll
            for (int ai = 0; ai < 2; ++ai)
#pragma unroll
                for (int m = 0; m < 4; ++m) { const int head = 2 * (pn - 12) + ai, dv = wr * 64 + m * 16 + fr;
                    bf16_t* rp = VT + gbase + ((size_t)(b * 8 + head) * 128 + dv) * S + t0 + wc * 32 + 8 * fq;
#pragma unroll
                    for (int bj = 0; bj < 2; ++bj) { const f32x4 v0 = acc[ai][bj][m][0], v1 = acc[ai][bj][m][1];
                        u32x4 w; w.x = pk_bf16(v0[0], v0[1]); w.y = pk_bf16(v0[2], v0[3]); w.z = pk_bf16(v1[0], v1[1]); w.w = pk_bf16(v1[2], v1[3]);
                        *(u32x4*)(rp + bj * 128) = w; } }
        } else {
#pragma unroll
            for (int ai = 0; ai < 2; ++ai)
#pragma unroll
                for (int m = 0; m < 4; ++m) { bf16_t* rp = Z + (size_t)(pm * 256 + ai * 128 + wr * 64 + m * 16 + fr) * DMIX + (pn - 16) * 256 + wc * 32 + 8 * fq;
#pragma unroll
                    for (int bj = 0; bj < 2; ++bj) { const f32x4 v0 = acc[ai][bj][m][0], v1 = acc[ai][bj][m][1];
                        u32x4 w; w.x = pk_bf16(silu_f(v0[0]), silu_f(v0[1])); w.y = pk_bf16(silu_f(v0[2]), silu_f(v0[3])); w.z = pk_bf16(silu_f(v1[0]), silu_f(v1[1])); w.w = pk_bf16(silu_f(v1[2]), silu_f(v1[3]));
                        *(u32x4*)(rp + bj * 128) = w; } }
        }
    }
};

struct RItem { int S, m0, h, nsc, sc; const bf16_t* vt; };
__device__ __forceinline__ RItem ritem(const Ctx& F, int it) {
    RItem r;
    if (it < 2048) { const int bh = it >> 5; r.sc = it & 31; r.S = S_P; r.nsc = 32; r.h = bh & 7; r.m0 = (bh >> 3) * S_P + r.sc * 256; r.vt = F.VT + (size_t)bh * 128 * S_P + r.sc * 256; }
    else { const int q = it - 2048, bh = q >> 4; r.sc = q & 15; r.S = S_S; r.nsc = 16; r.h = bh & 7; r.m0 = T_P + (bh >> 3) * S_S + r.sc * 256; r.vt = F.VT + (size_t)64 * 128 * S_P + (size_t)bh * 128 * S_S + r.sc * 256; }
    return r;
}
__device__ __forceinline__ float log2_gamma(const float* dec, int h) { return log1pf(-exp2f(-dec[h])) * 1.4426950408889634f; }

__device__ __forceinline__ void ra_item(const Ctx& F, int it, LAS unsigned char* lds) {
    const RItem R = ritem(F, it);
    const int tid = F.tid, w = F.wave, lane = F.lane, l15 = lane & 15, g = lane >> 4;
    LAS unsigned char* Kl = lds;
    LAS unsigned char* Vl = lds + 69632;
#pragma unroll
    for (int p = 0; p < 8; ++p) { const int idx = p * NTHR + tid, row = idx >> 4, c = idx & 15;
        const u32x4 v = *(const u32x4*)(F.Kb + (size_t)(R.m0 + row) * DM + R.h * 128 + c * 8);
        LAS u32x2* d = (LAS u32x2*)(Kl + row * 264 + c * 16); d[0] = (u32x2){v.x, v.y}; d[1] = (u32x2){v.z, v.w}; }
#pragma unroll
    for (int p = 0; p < 8; ++p) { const int idx = p * NTHR + tid, row = idx >> 5, c = idx & 31;
        const u32x4 v = *(const u32x4*)(R.vt + (size_t)row * R.S + c * 8);
        *(LAS u32x4*)(Vl + row * 528 + c * 16) = v; }
    __syncthreads();
    const int dir = w >> 2, dk0 = (w & 3) * 32;
    const float lg2 = log2_gamma(dir ? F.dec_b : F.dec_f, R.h);
    f32x4 acc[2][8];
#pragma unroll
    for (int mt = 0; mt < 2; ++mt)
#pragma unroll
        for (int nt = 0; nt < 8; ++nt) acc[mt][nt] = (f32x4){0.f, 0.f, 0.f, 0.f};
    const LAS bf16_t* Ks = (const LAS bf16_t*)Kl;
#pragma unroll 2
    for (int kk = 0; kk < 8; ++kk) {
        float wj[8];
#pragma unroll
        for (int e = 0; e < 8; ++e) { const int j = 32 * kk + 8 * g + e; wj[e] = __builtin_amdgcn_exp2f(lg2 * (float)(dir ? j : 255 - j)); }
        bf16x8 af[2];
#pragma unroll
        for (int mt = 0; mt < 2; ++mt) { const int dk = dk0 + 16 * mt + l15; float t[8];
#pragma unroll
            for (int e = 0; e < 8; ++e) t[e] = __uint_as_float((unsigned)Ks[(32 * kk + 8 * g + e) * 132 + dk] << 16) * wj[e];
            u32x4 pa; pa.x = pk_bf16(t[0], t[1]); pa.y = pk_bf16(t[2], t[3]); pa.z = pk_bf16(t[4], t[5]); pa.w = pk_bf16(t[6], t[7]);
            af[mt] = __builtin_bit_cast(bf16x8, pa); }
#pragma unroll
        for (int nt = 0; nt < 8; ++nt) { const bf16x8 bfr = *(const LAS bf16x8*)(Vl + (16 * nt + l15) * 528 + (32 * kk + 8 * g) * 2);
#pragma unroll
            for (int mt = 0; mt < 2; ++mt) acc[mt][nt] = __builtin_amdgcn_mfma_f32_16x16x32_bf16(af[mt], bfr, acc[mt][nt], 0, 0, 0); }
    }
    bf16_t* kv = F.KV + (size_t)it * 32768 + dir * 16384;
#pragma unroll
    for (int mt = 0; mt < 2; ++mt)
#pragma unroll
        for (int nt = 0; nt < 8; ++nt) { const f32x4 v = acc[mt][nt]; u32x2 o; o.x = pk_bf16(v[0], v[1]); o.y = pk_bf16(v[2], v[3]);
            *(u32x2*)(kv + (16 * nt + l15) * 128 + dk0 + 16 * mt + 4 * g) = o; }
    __syncthreads();
}

__device__ __forceinline__ void pool_item(const Ctx& F, int pt) {
    const int cg8 = F.tid & 127, tq = F.tid >> 7, ch = 8 * cg8, half = 1 << (cg8 >> 5);
    const int m0 = pt * 64 + tq * 16; int b16, pos0; row_info(m0, b16, pos0);
    const int S = m0 < T_P ? S_P : S_S; const int mseq = m0 - pos0;
    const bf16_t* ub = F.U + (size_t)mseq * DM + ch;
    float ps[8];
    { const f32x4 a = *(const f32x4*)(F.pool_scale + ch), b = *(const f32x4*)(F.pool_scale + ch + 4); ps[0] = a.x; ps[1] = a.y; ps[2] = a.z; ps[3] = a.w; ps[4] = b.x; ps[5] = b.y; ps[6] = b.z; ps[7] = b.w; }
    float sum[8];
#pragma unroll
    for (int e = 0; e < 8; ++e) sum[e] = 0.f;
    { const int lo = max(pos0 - half, 0), hi = min(pos0 + half, S);
      for (int s = lo; s < hi; ++s) { const u32x4 v = *(const u32x4*)(ub + (size_t)s * DM);
          sum[0] += bf_lo(v.x); sum[1] += bf_hi(v.x); sum[2] += bf_lo(v.y); sum[3] += bf_hi(v.y); sum[4] += bf_lo(v.z); sum[5] += bf_hi(v.z); sum[6] += bf_lo(v.w); sum[7] += bf_hi(v.w); } }
    for (int r = 0; r < 16; ++r) {
        const int pos = pos0 + r;
        if (r > 0) {
            const int add = pos + half - 1, rem = pos - 1 - half;
            if (add < S) { const u32x4 v = *(const u32x4*)(ub + (size_t)add * DM);
                sum[0] += bf_lo(v.x); sum[1] += bf_hi(v.x); sum[2] += bf_lo(v.y); sum[3] += bf_hi(v.y); sum[4] += bf_lo(v.z); sum[5] += bf_hi(v.z); sum[6] += bf_lo(v.w); sum[7] += bf_hi(v.w); }
            if (rem >= 0) { const u32x4 v = *(const u32x4*)(ub + (size_t)rem * DM);
                sum[0] -= bf_lo(v.x); sum[1] -= bf_hi(v.x); sum[2] -= bf_lo(v.y); sum[3] -= bf_hi(v.y); sum[4] -= bf_lo(v.z); sum[5] -= bf_hi(v.z); sum[6] -= bf_lo(v.w); sum[7] -= bf_hi(v.w); }
        }
        const int lo = max(pos - half, 0), hi = min(pos + half, S); const float inv = 1.0f / (float)(hi - lo);
        const u32x4 c = *(const u32x4*)(ub + (size_t)pos * DM);
        bf16_t* zp = F.Z + (size_t)(mseq + pos) * DMIX + ch;
        const u32x4 z = *(const u32x4*)zp;
        float y[8];
        y[0] = (sum[0] * inv - bf_lo(c.x)) * ps[0] * bf_lo(z.x); y[1] = (sum[1] * inv - bf_hi(c.x)) * ps[1] * bf_hi(z.x);
        y[2] = (sum[2] * inv - bf_lo(c.y)) * ps[2] * bf_lo(z.y); y[3] = (sum[3] * inv - bf_hi(c.y)) * ps[3] * bf_hi(z.y);
        y[4] = (sum[4] * inv - bf_lo(c.z)) * ps[4] * bf_lo(z.z); y[5] = (sum[5] * inv - bf_hi(c.z)) * ps[5] * bf_hi(z.z);
        y[6] = (sum[6] * inv - bf_lo(c.w)) * ps[6] * bf_lo(z.w); y[7] = (sum[7] * inv - bf_hi(c.w)) * ps[7] * bf_hi(z.w);
        u32x4 o; o.x = pk_bf16(y[0], y[1]); o.y = pk_bf16(y[2], y[3]); o.z = pk_bf16(y[4], y[5]); o.w = pk_bf16(y[6], y[7]);
        *(u32x4*)zp = o;
    }
}

__device__ __forceinline__ void rb_scan(const Ctx& F) {
    for (int q = F.bid; q < 1024; q += F.G) {
        const int seq = q >> 3, dir = (q >> 2) & 1, quarter = q & 3;
        const int nsc = seq < 64 ? 32 : 16, it0 = seq < 64 ? seq * 32 : 2048 + (seq - 64) * 16, h = seq & 7;
        const float Gd = __builtin_amdgcn_exp2f(256.0f * log2_gamma(dir ? F.dec_b : F.dec_f, h));
        bf16_t* base = F.KV + (size_t)it0 * 32768 + dir * 16384 + quarter * 4096 + F.tid * 8;
        float st[8];
#pragma unroll
        for (int e = 0; e < 8; ++e) st[e] = 0.f;
        for (int s0 = 0; s0 < nsc; s0 += 4) {
            u32x4 v[4];
#pragma unroll
            for (int u = 0; u < 4; ++u) { const int sc = dir ? nsc - 1 - (s0 + u) : s0 + u; v[u] = *(const u32x4*)(base + (size_t)sc * 32768); }
#pragma unroll
            for (int u = 0; u < 4; ++u) { const int sc = dir ? nsc - 1 - (s0 + u) : s0 + u;
                u32x4 o; o.x = pk_bf16(st[0], st[1]); o.y = pk_bf16(st[2], st[3]); o.z = pk_bf16(st[4], st[5]); o.w = pk_bf16(st[6], st[7]);
                *(u32x4*)(base + (size_t)sc * 32768) = o;
                st[0] = st[0] * Gd + bf_lo(v[u].x); st[1] = st[1] * Gd + bf_hi(v[u].x); st[2] = st[2] * Gd + bf_lo(v[u].y); st[3] = st[3] * Gd + bf_hi(v[u].y);
                st[4] = st[4] * Gd + bf_lo(v[u].z); st[5] = st[5] * Gd + bf_hi(v[u].z); st[6] = st[6] * Gd + bf_lo(v[u].w); st[7] = st[7] * Gd + bf_hi(v[u].w); }
        }
    }
}

__device__ __forceinline__ unsigned rc_voff(int lane, int v, unsigned pitch) { const int rsub = lane >> 4, cpos = lane & 15; return (unsigned)rsub * pitch + (unsigned)((cpos ^ (4 * v + rsub)) << 4); }
__device__ __forceinline__ void rc_issue_A(const Ctx& F, const RItem& R, int h2, LAS unsigned char* buf, int w, int lane) {
    const bool isk = w < 4; const unsigned pitch = isk ? 2048u : 2u * (unsigned)R.S;
    const char* ub = isk ? (const char*)(F.Kb + (size_t)(R.m0 + 128 * h2) * DM + R.h * 128) : (const char*)(R.vt + 128 * h2);
    LAS unsigned char* lb = buf + (isk ? 0 : 32768) + (w & 3) * 8192;
    unsigned vo[4];
#pragma unroll
    for (int v = 0; v < 4; ++v) vo[v] = rc_voff(lane, v, pitch);
#pragma unroll
    for (int i = 0; i < 8; ++i) {
        const int qq = 8 * (w & 3) + i;
        __builtin_amdgcn_global_load_lds((const unsigned*)(ub + (size_t)(4 * qq) * pitch + vo[i & 3]), (LAS unsigned*)(lb + i * 1024), 16, 0, 0);
    }
}
__device__ __forceinline__ void rc_issue_B(const Ctx& F, int it, LAS unsigned char* buf, int w, int lane) {
    const char* ub = (const char*)(F.KV + (size_t)it * 32768) + w * 8192;
    LAS unsigned char* lb = buf + w * 8192;
    unsigned vo[4];
#pragma unroll
    for (int v = 0; v < 4; ++v) vo[v] = rc_voff(lane, v, 256u);
#pragma unroll
    for (int i = 0; i < 8; ++i)
        __builtin_amdgcn_global_load_lds((const unsigned*)(ub + i * 1024 + vo[i & 3]), (LAS unsigned*)(lb + i * 1024), 16, 0, 0);
}
__device__ __forceinline__ void rc_load_q(const Ctx& F, const RItem& R, int w, int l15, int g, bf16x8 (&qf)[2][4]) {
#pragma unroll
    for (int n2 = 0; n2 < 2; ++n2)
#pragma unroll
        for (int kk = 0; kk < 4; ++kk) qf[n2][kk] = *(const bf16x8*)(F.Q + (size_t)(R.m0 + 32 * w + 16 * n2 + l15) * DM + R.h * 128 + 32 * kk + 8 * g);
}
__device__ __forceinline__ void rc_half(const LAS unsigned char* buf, const LAS float* tab, int h2, const bf16x8 (&qf)[2][4], f32x4 (&o)[8][2],
                                        const float (&fa)[2], const float (&ba)[2], const int (&irow)[2], int l15, int g) {
#pragma unroll 1
    for (int k2 = 0; k2 < 4; ++k2) {
        f32x4 s[2][2];
#pragma unroll
        for (int jj = 0; jj < 2; ++jj)
#pragma unroll
            for (int n2 = 0; n2 < 2; ++n2) s[jj][n2] = (f32x4){0.f, 0.f, 0.f, 0.f};
#pragma unroll
        for (int jj = 0; jj < 2; ++jj)
#pragma unroll
            for (int kk = 0; kk < 4; ++kk) { const bf16x8 a = *(const LAS bf16x8*)(buf + (16 * (2 * k2 + jj) + l15) * 256 + (((4 * kk + g) ^ l15) << 4));
#pragma unroll
                for (int n2 = 0; n2 < 2; ++n2) s[jj][n2] = __builtin_amdgcn_mfma_f32_16x16x32_bf16(a, qf[n2][kk], s[jj][n2], 0, 0, 0); }
        const int jb = 128 * h2 + 32 * k2 + 4 * g;
        f32x4 tf[2], tb[2];
#pragma unroll
        for (int jj = 0; jj < 2; ++jj) { tf[jj] = *(const LAS f32x4*)(tab + jb + 16 * jj); tb[jj] = *(const LAS f32x4*)(tab + 256 + jb + 16 * jj); }
        bf16x8 pf[2];
#pragma unroll
        for (int n2 = 0; n2 < 2; ++n2) { float p[8];
#pragma unroll
            for (int jj = 0; jj < 2; ++jj)
#pragma unroll
                for (int r = 0; r < 4; ++r) { const int j = jb + 16 * jj + r; const float d = (j <= irow[n2]) ? fa[n2] * tf[jj][r] : ba[n2] * tb[jj][r]; p[4 * jj + r] = s[jj][n2][r] * d; }
            u32x4 pp; pp.x = pk_bf16(p[0], p[1]); pp.y = pk_bf16(p[2], p[3]); pp.z = pk_bf16(p[4], p[5]); pp.w = pk_bf16(p[6], p[7]);
            pf[n2] = __builtin_bit_cast(bf16x8, pp); }
#pragma unroll
        for (int mt = 0; mt < 8; ++mt) { const LAS unsigned char* vp = buf + 32768 + (16 * mt + l15) * 256 + 8 * (g & 1); const int c0 = 4 * k2 + (g >> 1);
            const u32x2 lo = *(const LAS u32x2*)(vp + ((c0 ^ l15) << 4)), hi = *(const LAS u32x2*)(vp + (((c0 + 2) ^ l15) << 4));
            const bf16x8 a = __builtin_bit_cast(bf16x8, (u32x4){lo.x, lo.y, hi.x, hi.y});
#pragma unroll
            for (int n2 = 0; n2 < 2; ++n2) o[mt][n2] = __builtin_amdgcn_mfma_f32_16x16x32_bf16(a, pf[n2], o[mt][n2], 0, 0, 0);
            if (mt & 1) __builtin_amdgcn_sched_barrier(0); }
    }
}
#define RC_WAIT_BAR() do { asm volatile("s_waitcnt vmcnt(0)" ::: "memory"); __syncthreads(); } while (0)
__device__ __forceinline__ void rc_phase(const Ctx& F, LAS unsigned char* lds) {
    const int tid = F.tid, w = F.wave;
    const int nitems = (3072 - F.bid + F.G - 1) / F.G;
    if (nitems <= 0) return;
    LAS float* tabs = (LAS float*)(lds + 131072);
    RItem R = ritem(F, F.bid);
    bf16x8 qf[2][4];
    rc_issue_A(F, R, 0, lds, w, F.lane);
    rc_load_q(F, R, w, F.lane & 15, F.lane >> 4, qf);
    for (int n = 0; n < nitems; ++n) {
        int lane_o = F.lane; asm volatile("" : "+v"(lane_o));
        const int lane = lane_o, l15 = lane & 15, g = lane >> 4;
        const int it = F.bid + n * F.G, par = n & 1;
        LAS unsigned char* b0 = lds + par * 65536; LAS unsigned char* b1 = lds + (par ^ 1) * 65536;
        LAS float* tab = tabs + par * 512;
        const float lg2f = log2_gamma(F.dec_f, R.h), lg2b = log2_gamma(F.dec_b, R.h);
        tab[tid] = tid < 256 ? __builtin_amdgcn_exp2f(-lg2f * (float)tid) : __builtin_amdgcn_exp2f(lg2b * (float)(tid - 256));
        float fa[2], ba[2]; int irow[2];
#pragma unroll
        for (int n2 = 0; n2 < 2; ++n2) { irow[n2] = 32 * w + 16 * n2 + l15; fa[n2] = __builtin_amdgcn_exp2f(lg2f * (float)irow[n2]); ba[n2] = __builtin_amdgcn_exp2f(-lg2b * (float)irow[n2]); }
        f32x4 o[8][2];
#pragma unroll
        for (int mt = 0; mt < 8; ++mt)
#pragma unroll
            for (int n2 = 0; n2 < 2; ++n2) o[mt][n2] = (f32x4){0.f, 0.f, 0.f, 0.f};
        RC_WAIT_BAR();
        rc_issue_A(F, R, 1, b1, w, lane);
        rc_half(b0, tab, 0, qf, o, fa, ba, irow, l15, g);
        RC_WAIT_BAR();
        rc_issue_B(F, it, b0, w, lane);
        rc_half(b1, tab, 1, qf, o, fa, ba, irow, l15, g);
        RC_WAIT_BAR();
        const bool more = (n + 1 < nitems);
        RItem Rn = R;
        if (more) { Rn = ritem(F, it + F.G); rc_issue_A(F, Rn, 0, b1, w, lane); }
        {
            float qfd[2], qbd[2];
#pragma unroll
            for (int n2 = 0; n2 < 2; ++n2) { qfd[n2] = __builtin_amdgcn_exp2f(lg2f * (float)(irow[n2] + 1)); qbd[n2] = __builtin_amdgcn_exp2f(lg2b * (float)(256 - irow[n2])); }
#pragma unroll
            for (int mt = 0; mt < 8; ++mt) {
                f32x4 tf[2], tb[2];
#pragma unroll
                for (int n2 = 0; n2 < 2; ++n2) { tf[n2] = (f32x4){0.f, 0.f, 0.f, 0.f}; tb[n2] = (f32x4){0.f, 0.f, 0.f, 0.f}; }
#pragma unroll
                for (int kk = 0; kk < 4; ++kk) { const LAS unsigned char* sp = b0 + (16 * mt + l15) * 256 + (((4 * kk + g) ^ l15) << 4);
                    const bf16x8 af = *(const LAS bf16x8*)sp, ab = *(const LAS bf16x8*)(sp + 32768);
#pragma unroll
                    for (int n2 = 0; n2 < 2; ++n2) { tf[n2] = __builtin_amdgcn_mfma_f32_16x16x32_bf16(af, qf[n2][kk], tf[n2], 0, 0, 0); tb[n2] = __builtin_amdgcn_mfma_f32_16x16x32_bf16(ab, qf[n2][kk], tb[n2], 0, 0, 0); } }
#pragma unroll
                for (int n2 = 0; n2 < 2; ++n2) o[mt][n2] += tf[n2] * qfd[n2] + tb[n2] * qbd[n2];
                __builtin_amdgcn_sched_barrier(0);
            }
        }
        bf16_t* zbase = F.Z + (size_t)(R.m0 + 32 * w + l15) * DMIX + 1024 + R.h * 128 + 4 * g;
        if (more) { R = Rn; rc_load_q(F, R, w, l15, g, qf); }
#pragma unroll
        for (int n2 = 0; n2 < 2; ++n2) {
            float s1 = 0.f;
#pragma unroll
            for (int mt = 0; mt < 8; ++mt) s1 += (o[mt][n2][0] + o[mt][n2][1]) + (o[mt][n2][2] + o[mt][n2][3]);
            s1 += __shfl_xor(s1, 16); s1 += __shfl_xor(s1, 32);
            const float mu = s1 * (1.0f / 128.0f); float s2 = 0.f;
#pragma unroll
            for (int mt = 0; mt < 8; ++mt) { const f32x4 d = o[mt][n2] - mu; s2 += (d[0] * d[0] + d[1] * d[1]) + (d[2] * d[2] + d[3] * d[3]); }
            s2 += __shfl_xor(s2, 16); s2 += __shfl_xor(s2, 32);
            const float rs = rsqrtf(s2 * (1.0f / 128.0f) + EPS);
            bf16_t* zp = zbase + (size_t)(16 * n2) * DMIX;
#pragma unroll
            for (int mt = 0; mt < 8; ++mt) { const u32x2 z = *(const u32x2*)(zp + 16 * mt); const f32x4 d = (o[mt][n2] - mu) * rs;
                u32x2 ov; ov.x = pk_bf16(d[0] * bf_lo(z.x), d[1] * bf_hi(z.x)); ov.y = pk_bf16(d[2] * bf_lo(z.y), d[3] * bf_hi(z.y));
                *(u32x2*)(zp + 16 * mt) = ov; }
        }
    }
    RC_WAIT_BAR();
}

struct SchedOut {
    const char* Y; const char* W; int G, c;
    __device__ __forceinline__ bool next(int i, pg8::Unit& u) const {
        int pm, pn; if (!pg8::order_next(i, G, c, T_ALL / 256, DM / 256, pm, pn)) return false;
        const size_t tstep = (size_t)256 * DMIX * 2; u.a = Y + (size_t)pm * tstep; u.b = W + (size_t)pn * tstep; u.pm = pm; u.pn = pn; return true;
    }
};
struct EpiOut {
    bf16_t* O; float* part;
    __device__ __forceinline__ void operator()(const f32x4 (&acc)[2][2][4][2], const pg8::Unit& u, int wr, int wc, int fr, int fq) const {
#pragma unroll
        for (int ai = 0; ai < 2; ++ai)
#pragma unroll
            for (int m = 0; m < 4; ++m) { const size_t row = (size_t)(u.pm * 256 + ai * 128 + wr * 64 + m * 16 + fr); bf16_t* rp = O + row * DM + u.pn * 256 + wc * 32 + 8 * fq; float ss = 0.f;
#pragma unroll
                for (int bj = 0; bj < 2; ++bj) { const f32x4 v0 = acc[ai][bj][m][0], v1 = acc[ai][bj][m][1];
                    ss += (v0[0] * v0[0] + v0[1] * v0[1]) + (v0[2] * v0[2] + v0[3] * v0[3]) + (v1[0] * v1[0] + v1[1] * v1[1]) + (v1[2] * v1[2] + v1[3] * v1[3]);
                    u32x4 w; w.x = pk_bf16(v0[0], v0[1]); w.y = pk_bf16(v0[2], v0[3]); w.z = pk_bf16(v1[0], v1[1]); w.w = pk_bf16(v1[2], v1[3]);
                    *(u32x4*)(rp + bj * 128) = w; }
                ss += __shfl_xor(ss, 16); ss += __shfl_xor(ss, 32);
                if (fq == 0) part[row * 16 + u.pn * 4 + wc] = ss; }
    }
};

__device__ __forceinline__ void p7_final(const Ctx& F) {
    const int gw = F.bid * NWAVES + F.wave, NGW = F.G * NWAVES;
    for (int gi = gw; gi < T_ALL / 16; gi += NGW) {
        const int m0 = gi * 16; int b16, pos; row_info(m0, b16, pos);
        const float* md = F.mod + b16 * 3072 + 2048;
        f32x4 gg[4];
#pragma unroll
        for (int j = 0; j < 4; ++j) { const int c = 4 * F.lane + 256 * j; gg[j] = *(const f32x4*)(F.g_post + c) * *(const f32x4*)(md + c); }
        for (int r = 0; r < 16; ++r) {
            const int m = m0 + r;
            float ss = F.part[(size_t)m * 16 + (F.lane & 15)];
            ss += __shfl_xor(ss, 1); ss += __shfl_xor(ss, 2); ss += __shfl_xor(ss, 4); ss += __shfl_xor(ss, 8);
            const float rstd = rsqrtf(ss * (1.f / DM) + EPS);
            const f32x4* xr = (const f32x4*)x_row(F, m) + F.lane;
            const u32x2* orow = (const u32x2*)(F.OUTB + (size_t)m * DM) + F.lane;
            f32x4* dst = (f32x4*)(F.out + (size_t)m * DM) + F.lane;
#pragma unroll
            for (int j = 0; j < 4; ++j) { const u32x2 ov = orow[64 * j]; const f32x4 xv = xr[64 * j];
                f32x4 y; y.x = xv.x + gg[j].x * (bf_lo(ov.x) * rstd); y.y = xv.y + gg[j].y * (bf_hi(ov.x) * rstd); y.z = xv.z + gg[j].z * (bf_lo(ov.y) * rstd); y.w = xv.w + gg[j].w * (bf_hi(ov.y) * rstd);
                dst[64 * j] = y; }
        }
    }
}

#ifndef PROBE_DUP
#define PROBE_DUP 0
#endif
__global__ void __launch_bounds__(NTHR, 2) fwd_megakernel(Args args) {
    extern __shared__ __attribute__((aligned(16))) unsigned char smem[];
    cg::grid_group grid = cg::this_grid();
    LAS unsigned char* lds = (LAS unsigned char*)smem;
    Ctx F;
    F.xp = args.in[0]; F.xs = args.in[1]; F.cp = args.in[2]; F.cs = args.in[3]; F.ada_w = args.in[4]; F.ada_b = args.in[5]; F.g_pre = args.in[6]; F.g_post = args.in[7];
    F.w_in = args.in[8]; F.pool_w = args.in[9]; F.pool_scale = args.in[10]; F.dec_f = args.in[11]; F.dec_b = args.in[12]; F.w_out = args.in[13];
    F.out = args.out; F.ws = args.ws;
    F.mod = (float*)(args.ws + WS_MOD); F.WinT = (bf16_t*)(args.ws + WS_WIN); F.WoutT = (bf16_t*)(args.ws + WS_WOUT); F.part = (float*)(args.ws + WS_PART);
    F.H = (bf16_t*)(args.ws + WS_H); F.U = (bf16_t*)(args.ws + WS_U); F.Q = (bf16_t*)(args.ws + WS_Q); F.Kb = (bf16_t*)(args.ws + WS_K); F.VT = (bf16_t*)(args.ws + WS_VT);
    F.Z = (bf16_t*)args.out; F.KV = (bf16_t*)(args.ws + WS_H); F.OUTB = (bf16_t*)(args.ws + WS_U);
    F.tid = threadIdx.x; F.lane = F.tid & 63; F.wave = __builtin_amdgcn_readfirstlane(F.tid >> 6); F.G = gridDim.x; F.bid = blockIdx.x;
    const int lo = args.ph_lo, hi = args.ph_hi;
#define IN(k) (lo <= (k) && (k) < hi)
#define SEAM(k) do { if (IN(k) && IN((k) + 1)) grid.sync(); } while (0)
    if (IN(0)) { p0_prologue(F, lds); if (PROBE_DUP == 10) { __syncthreads(); p0_prologue(F, lds); } } SEAM(0);
    if (IN(1)) { p1_prenorm(F); if (PROBE_DUP == 11) p1_prenorm(F); } SEAM(1);
    if (IN(2)) { for (int rep = 0; rep < (PROBE_DUP == 2 ? 2 : 1); ++rep) { SchedIn S{(const char*)F.H, (const char*)F.WinT, F.G, F.bid}; EpiIn E{F.U, F.Q, F.Kb, F.VT, F.Z}; pg8::gemm_phase<EpiIn, SchedIn>(lds, DM, S, E); } } SEAM(2);
    if (IN(3)) {
        if (F.bid & 1) for (int pt = F.bid; pt < T_ALL / 64; pt += F.G) pool_item(F, pt);
        for (int rep = 0; rep < (PROBE_DUP == 3 ? 2 : 1); ++rep) for (int it = F.bid; it < 3072; it += F.G) ra_item(F, it, lds);
        if (!(F.bid & 1)) for (int pt = F.bid; pt < T_ALL / 64; pt += F.G) pool_item(F, pt);
    } SEAM(3);
    if (IN(4)) { rb_scan(F); } SEAM(4);
    if (IN(5)) { rc_phase(F, lds); } SEAM(5);
    if (IN(6)) { for (int rep = 0; rep < (PROBE_DUP == 6 ? 2 : 1); ++rep) { SchedOut S{(const char*)F.Z, (const char*)F.WoutT, F.G, F.bid}; EpiOut E{F.OUTB, F.part}; pg8::gemm_phase<EpiOut, SchedOut>(lds, DMIX, S, E); } } SEAM(6);
    if (IN(7)) { p7_final(F); if (PROBE_DUP == 17) p7_final(F); }
}

#ifndef N_LAUNCH_MODE
#define N_LAUNCH_MODE 1
#endif

extern "C" void kernel_launch(void* const* d_in, const int* in_sizes, int n_in, void* d_out, int out_size, void* d_ws, size_t ws_size, hipStream_t stream) {
    static int grid = 0;
    if (grid == 0) {
        if (n_in != 14 || out_size != T_ALL * DM || ws_size < WS_END) { fprintf(stderr, "kernel_launch: unexpected shapes (n_in %d out %d ws %zu)\n", n_in, out_size, ws_size); grid = -1; return; }
        int dev = 0, cus = 0, per_cu = 0;
        hipGetDevice(&dev); hipDeviceGetAttribute(&cus, hipDeviceAttributeMultiprocessorCount, dev);
        if (hipFuncSetAttribute((const void*)fwd_megakernel, hipFuncAttributeMaxDynamicSharedMemorySize, LDS_BYTES) != hipSuccess) { fprintf(stderr, "kernel_launch: hipFuncSetAttribute failed\n"); grid = -1; return; }
        if (hipOccupancyMaxActiveBlocksPerMultiprocessor(&per_cu, (const void*)fwd_megakernel, NTHR, LDS_BYTES) != hipSuccess || per_cu < 1) { fprintf(stderr, "kernel_launch: occupancy query says %d\n", per_cu); per_cu = 1; }
        (void)hipGetLastError();
        grid = cus * per_cu;
        fprintf(stderr, "kernel_launch: cus %d per_cu %d grid %d\n", cus, per_cu, grid);
    }
    if (grid < 0) return;
    Args a{};
    for (int i = 0; i < 14; ++i) a.in[i] = (const float*)d_in[i];
    a.out = (float*)d_out; a.ws = (unsigned char*)d_ws;
#if N_LAUNCH_MODE == 1
    a.ph_lo = 0; a.ph_hi = 8;
    void* kargs[] = {&a};
    hipError_t e = hipLaunchCooperativeKernel((const void*)fwd_megakernel, dim3(grid), dim3(NTHR), kargs, LDS_BYTES, stream);
    if (e != hipSuccess) fprintf(stderr, "kernel_launch: cooperative launch failed: %s (grid %d)\n", hipGetErrorString(e), grid);
#else
    for (int p = 0; p < 8; ++p) { a.ph_lo = p; a.ph_hi = p + 1; hipLaunchKernelGGL(fwd_megakernel, dim3(grid), dim3(NTHR), LDS_BYTES, stream, a); }
#endif
}
```

```cpp
#include <hip/hip_runtime.h>
#include <hip/hip_cooperative_groups.h>
#include <cstdio>
#include <cstdint>
namespace cg = cooperative_groups;

#define LAS __attribute__((address_space(3)))
typedef unsigned short bf16_t;
typedef short bf16x8 __attribute__((ext_vector_type(8)));
typedef float f32x4 __attribute__((ext_vector_type(4)));
typedef unsigned u32x4 __attribute__((ext_vector_type(4)));
typedef unsigned u32x2 __attribute__((ext_vector_type(2)));

constexpr int NTHR = 512, NWAVES = 8;
constexpr int DM = 1024, DIN = 6144, DMIX = 2048;
constexpr int T_P = 65536, T_S = 32768, T_ALL = 98304, S_P = 8192, S_S = 4096;
constexpr float EPS = 1e-6f;
constexpr size_t MiB = 1u << 20;
constexpr size_t WS_MOD = 0;
constexpr size_t WS_WIN = 1 * MiB;
constexpr size_t WS_WOUT = 13 * MiB;
constexpr size_t WS_PART = 17 * MiB;
constexpr size_t WS_H = 24 * MiB;
constexpr size_t WS_U = 216 * MiB;
constexpr size_t WS_Q = 408 * MiB;
constexpr size_t WS_K = 600 * MiB;
constexpr size_t WS_VT = 792 * MiB;
constexpr size_t WS_END = 984 * MiB;
constexpr int LDS_BYTES = 147456;

__device__ __forceinline__ unsigned pk_bf16(float lo, float hi) { unsigned r; asm("v_cvt_pk_bf16_f32 %0, %1, %2" : "=v"(r) : "v"(lo), "v"(hi)); return r; }
__device__ __forceinline__ float bf_lo(unsigned u) { return __uint_as_float(u << 16); }
__device__ __forceinline__ float bf_hi(unsigned u) { return __uint_as_float(u & 0xffff0000u); }
__device__ __forceinline__ float wave_sum(float v) {
#pragma unroll
    for (int o = 1; o < 64; o <<= 1) v += __shfl_xor(v, o);
    return v;
}
__device__ __forceinline__ float silu_f(float z) { return z * __builtin_amdgcn_rcpf(1.0f + __builtin_amdgcn_exp2f(-1.4426950408889634f * z)); }
__device__ __forceinline__ void row_info(int m, int& b16, int& pos) { if (m < T_P) { b16 = m >> 13; pos = m & 8191; } else { const int mm = m - T_P; b16 = 8 + (mm >> 12); pos = mm & 4095; } }

namespace pg8 {
constexpr int BM = 256, BK = 64, HALF = 128, HTB = HALF * BK * 2, STAGE_BYTES = 8 * HTB, NXCD = 8, WGM = 8;
__host__ __device__ __forceinline__ int lds_byte(int r, int c) { const int st = (r >> 4) * 2 + (c >> 5), rr = r & 15, cc = c & 31, ob = rr * 64 + cc * 2; return st * 1024 + (ob ^ (((ob >> 9) & 1) << 5)); }
__host__ __device__ __forceinline__ void stage_rc(int b, int& R, int& C) { const int st = b / 1024, sb = b % 1024, swz = sb ^ (((sb >> 9) & 1) << 5); R = (st >> 1) * 16 + swz / 64; C = (st & 1) * 32 + (swz % 64) / 2; }
__host__ __device__ __forceinline__ int perm32(int rho) { const int n = rho >> 4, i = rho & 15; return 8 * (i >> 2) + 4 * n + (i & 3); }

struct Unit { const char* a; const char* b; int pm, pn; };

__device__ __forceinline__ bool order_next(int i, int G, int c, int nM, int nN, int& pm, int& pn) {
    const int nwg = nM * nN; const long L = (long)i * G + c; if (L >= nwg) return false;
    int wgid = (int)L; { const int q = nwg / NXCD, r = nwg % NXCD, xcd = wgid % NXCD, off = wgid / NXCD; wgid = (xcd < r ? xcd * (q + 1) : r * (q + 1) + (xcd - r) * q) + off; }
    const int nig = WGM * nN, gid = wgid / nig, fm = gid * WGM, gsz = (nM - fm) < WGM ? (nM - fm) : WGM;
    pm = fm + ((wgid % nig) % gsz); pn = (wgid % nig) / gsz; return true;
}

template <class Epi, class Sched>
__device__ __forceinline__ void gemm_phase(LAS unsigned char* lds, const int K, const Sched& S, const Epi& E) {
    const int tid = threadIdx.x, wid = __builtin_amdgcn_readfirstlane(tid >> 6), lane = tid & 63, wr = wid >> 2, wc = wid & 3, fr = lane & 15, fq = lane >> 4;
    const int nt = K / BK;
    unsigned voffA[2], voffB[2];
#pragma unroll
    for (int i = 0; i < 2; ++i) { int R, C; stage_rc(tid * 16 + i * 8192, R, C); const int Rb = (R & ~31) + perm32(R & 31);
        voffA[i] = (unsigned)(R * K + C) * 2u; voffB[i] = (unsigned)(Rb * K + C) * 2u; }
    const size_t kstep = (size_t)(BK * 2);
    const size_t hstep = (size_t)HALF * K * 2;
    const unsigned ldsw = (unsigned)wid * 1024u;
    const int aoff = lds_byte(wr * 64 + fr, fq * 8), boff = lds_byte(wc * 32 + fr, fq * 8);
#define PG8_SA(b, h) (((b) * 2 + (h)) * HTB)
#define PG8_SB(b, h) ((4 + (b) * 2 + (h)) * HTB)
#define PG8_STAGE(bufoff, gbase, voff) do { _Pragma("unroll") for (int _i = 0; _i < 2; ++_i) \
        __builtin_amdgcn_global_load_lds((const unsigned*)((const char*)(gbase) + (voff)[_i]), (LAS unsigned*)(lds + (bufoff) + ldsw + _i * 8192), 16, 0, 0); } while (0)
#define PG8_LDA(dst, b, h) do { _Pragma("unroll") for (int m = 0; m < 4; ++m) _Pragma("unroll") for (int k = 0; k < 2; ++k) dst[m][k] = *(const LAS bf16x8*)(lds + PG8_SA(b, h) + aoff + m * 2048 + k * 1024); } while (0)
#define PG8_LDB(dst, b, h) do { _Pragma("unroll") for (int n = 0; n < 2; ++n) _Pragma("unroll") for (int k = 0; k < 2; ++k) dst[n][k] = *(const LAS bf16x8*)(lds + PG8_SB(b, h) + boff + n * 2048 + k * 1024); } while (0)
#define PG8_MMA(ai, bj, At, Bt) do { __builtin_amdgcn_s_setprio(1); _Pragma("unroll") for (int m = 0; m < 4; ++m) _Pragma("unroll") for (int n = 0; n < 2; ++n) _Pragma("unroll") for (int k = 0; k < 2; ++k) \
        acc[ai][bj][m][n] = __builtin_amdgcn_mfma_f32_16x16x32_bf16(Bt[n][k], At[m][k], acc[ai][bj][m][n], 0, 0, 0); __builtin_amdgcn_s_setprio(0); } while (0)
#define PG8_WAIT_V(n) asm volatile("s_waitcnt vmcnt(" #n ")" ::: "memory")
#define PG8_WAIT_L(n) asm volatile("s_waitcnt lgkmcnt(" #n ")" ::: "memory")
#define PG8_BAR __builtin_amdgcn_s_barrier()
#define PG8_SCHED __builtin_amdgcn_sched_barrier(0)
    Unit cur, nxt; int ui = 0;
    if (!S.next(0, cur)) return;
    f32x4 acc[2][2][4][2];
#pragma unroll
    for (int a = 0; a < 2; ++a)
#pragma unroll
        for (int b = 0; b < 2; ++b)
#pragma unroll
            for (int m = 0; m < 4; ++m)
#pragma unroll
                for (int n = 0; n < 2; ++n) acc[a][b][m][n] = (f32x4){0.f, 0.f, 0.f, 0.f};
    bf16x8 At[4][2], B0[2][2], B1[2][2];
    const char* cA = cur.a; const char* cB = cur.b;
    PG8_STAGE(PG8_SB(0, 0), cB, voffB); PG8_STAGE(PG8_SB(0, 1), cB + hstep, voffB); PG8_STAGE(PG8_SA(0, 0), cA, voffA); PG8_STAGE(PG8_SA(0, 1), cA + hstep, voffA);
    if (wr == 1) PG8_BAR;
    PG8_WAIT_V(2); PG8_BAR;
    PG8_STAGE(PG8_SB(1, 0), cB + kstep, voffB); PG8_STAGE(PG8_SA(1, 0), cA + kstep, voffA); PG8_STAGE(PG8_SB(1, 1), cB + hstep + kstep, voffB);
    PG8_WAIT_V(6); PG8_BAR;
    for (;;) {
        const bool has_next = S.next(ui + 1, nxt);
        const char* nA = has_next ? nxt.a : cA; const char* nB = has_next ? nxt.b : cB;
        for (int t = 0; t < nt; t += 2) {
            const bool last = (t == nt - 2);
            const char* a1 = cA + (size_t)(t + 1) * kstep;
            const char* a2 = last ? nA : cA + (size_t)(t + 2) * kstep; const char* b2 = last ? nB : cB + (size_t)(t + 2) * kstep;
            const char* a3 = a2 + kstep; const char* b3 = b2 + kstep;
            PG8_LDB(B0, 0, 0); PG8_LDB(B1, 0, 1); PG8_SCHED; PG8_LDA(At, 0, 0); PG8_STAGE(PG8_SA(1, 1), a1 + hstep, voffA);
            PG8_WAIT_V(8); PG8_WAIT_L(0); PG8_BAR; PG8_MMA(0, 0, At, B0); PG8_MMA(0, 1, At, B1); PG8_BAR; PG8_SCHED;
            PG8_LDA(At, 0, 1); PG8_STAGE(PG8_SB(0, 0), b2, voffB); PG8_STAGE(PG8_SB(0, 1), b2 + hstep, voffB); PG8_STAGE(PG8_SA(0, 0), a2, voffA);
            PG8_WAIT_V(8); PG8_WAIT_L(0); PG8_BAR; PG8_MMA(1, 0, At, B0); PG8_MMA(1, 1, At, B1); PG8_BAR; PG8_SCHED;
            PG8_LDB(B0, 1, 0); PG8_LDB(B1, 1, 1); PG8_SCHED; PG8_LDA(At, 1, 0); PG8_STAGE(PG8_SA(0, 1), a2 + hstep, voffA);
            PG8_WAIT_V(8); PG8_WAIT_L(0); PG8_BAR; PG8_MMA(0, 0, At, B0); PG8_MMA(0, 1, At, B1); PG8_BAR; PG8_SCHED;
            PG8_LDA(At, 1, 1); PG8_STAGE(PG8_SB(1, 0), b3, voffB); PG8_STAGE(PG8_SB(1, 1), b3 + hstep, voffB); PG8_STAGE(PG8_SA(1, 0), a3, voffA);
            PG8_WAIT_V(8); PG8_WAIT_L(0); PG8_BAR; PG8_MMA(1, 0, At, B0); PG8_MMA(1, 1, At, B1); PG8_BAR; PG8_SCHED;
        }
        if (wr == 0) PG8_BAR;
        E(acc, cur, wr, wc, fr, fq);
        if (!has_next) break;
#pragma unroll
        for (int a = 0; a < 2; ++a)
#pragma unroll
            for (int b = 0; b < 2; ++b)
#pragma unroll
                for (int m = 0; m < 4; ++m)
#pragma unroll
                    for (int n = 0; n < 2; ++n) acc[a][b][m][n] = (f32x4){0.f, 0.f, 0.f, 0.f};
        cur = nxt; cA = nA; cB = nB; ++ui;
        if (wr == 1) PG8_BAR;
    }
    PG8_WAIT_V(0);
    PG8_BAR;
#undef PG8_SA
#undef PG8_SB
#undef PG8_STAGE
#undef PG8_LDA
#undef PG8_LDB
#undef PG8_MMA
#undef PG8_WAIT_V
#undef PG8_WAIT_L
#undef PG8_BAR
#undef PG8_SCHED
}
}

struct Args { const float* in[14]; float* out; unsigned char* ws; int ph_lo, ph_hi; };

struct Ctx {
    const float *xp, *xs, *cp, *cs, *ada_w, *ada_b, *g_pre, *g_post, *w_in, *pool_w, *pool_scale, *dec_f, *dec_b, *w_out;
    float* out; unsigned char* ws;
    float* mod; bf16_t *WinT, *WoutT; float* part; bf16_t *H, *U, *Q, *Kb, *VT, *Z, *KV, *OUTB;
    int tid, lane, wave, G, bid;
};
__device__ __forceinline__ const float* x_row(const Ctx& F, int m) { return m < T_P ? F.xp + (size_t)m * DM : F.xs + (size_t)(m - T_P) * DM; }

__device__ __forceinline__ int colmap(int rho) {
    const int pn = rho >> 8;
    if (pn < 4 || pn >= 12) return rho;
    const int s = rho & 255, bj = s >> 7, sp = s & 127;
    return 1024 * (pn >> 2) + (2 * (pn & 3) + (sp >> 6)) * 128 + 64 * bj + (sp & 63);
}
__device__ __forceinline__ void p0_write_tile(bf16_t* WT, int Kdst, int row0, int k0, LAS float* scr, int lane) {
    asm volatile("s_waitcnt lgkmcnt(0)" ::: "memory");
    const int c = lane & 7;
#pragma unroll
    for (int j = 0; j < 4; ++j) { const int n = (lane >> 3) + 8 * j; const LAS float* s = scr + (8 * c) * 33 + n;
        u32x4 o; o.x = pk_bf16(s[0 * 33], s[1 * 33]); o.y = pk_bf16(s[2 * 33], s[3 * 33]); o.z = pk_bf16(s[4 * 33], s[5 * 33]); o.w = pk_bf16(s[6 * 33], s[7 * 33]);
        *(u32x4*)(WT + (size_t)(row0 + n) * Kdst + k0 + 8 * c) = o; }
    asm volatile("s_waitcnt lgkmcnt(0)" ::: "memory");
}
__device__ __forceinline__ void p0_transpose_item(const float* W, int N, int k0, int n0src, bf16_t* WT, int Kdst, int row0, LAS float* scr, int lane) {
#pragma unroll 8
    for (int i = 0; i < 32; ++i) { const int kk = 2 * i + (lane >> 5); scr[kk * 33 + (lane & 31)] = W[(size_t)(k0 + kk) * N + n0src + (lane & 31)]; }
    p0_write_tile(WT, Kdst, row0, k0, scr, lane);
}
__device__ __forceinline__ void p0_fold_item(const Ctx& F, int item, LAS float* scr, int lane) {
    const int kb = item >> 5, nb = item & 31, k0 = 64 * kb, rho0 = 32 * nb, g = rho0 >> 8, d0 = rho0 & 255;
    const int kl = lane >> 3, dg = lane & 7;
    f32x4 acc[8];
#pragma unroll
    for (int q = 0; q < 8; ++q) acc[q] = (f32x4){0.f, 0.f, 0.f, 0.f};
    const float* pw0 = F.pool_w + (size_t)g * 65536 + d0 + 4 * dg;
    const float* wi0 = F.w_in + (size_t)(k0 + kl) * DIN + g * 256;
#pragma unroll 4
    for (int c = 0; c < 256; c += 4) {
        f32x4 pw[4];
#pragma unroll
        for (int cc = 0; cc < 4; ++cc) pw[cc] = *(const f32x4*)(pw0 + (size_t)(c + cc) * 256);
#pragma unroll
        for (int q = 0; q < 8; ++q) { const f32x4 wv = *(const f32x4*)(wi0 + (size_t)(8 * q) * DIN + c);
            acc[q] += wv.x * pw[0] + wv.y * pw[1] + wv.z * pw[2] + wv.w * pw[3]; }
    }
#pragma unroll
    for (int q = 0; q < 8; ++q)
#pragma unroll
        for (int e = 0; e < 4; ++e) scr[(kl + 8 * q) * 33 + 4 * dg + e] = acc[q][e];
    p0_write_tile(F.WinT, DM, rho0, k0, scr, lane);
}
__device__ __forceinline__ void p0_prologue(const Ctx& F, LAS unsigned char* lds) {
    LAS float* scr = (LAS float*)(lds + F.wave * 16384);
    if (F.bid < 48) {
        LAS float* sv = scr; LAS float* red = (LAS float*)(lds + F.wave * 16384 + 12288);
        const int kw0 = 128 * F.wave;
        for (int idx = F.lane; idx < 2048; idx += 64) { const int r = idx >> 7, kk = idx & 127;
            const float c = r < 8 ? F.cp[r * DM + kw0 + kk] : F.cs[(r - 8) * DM + kw0 + kk]; sv[idx] = silu_f(c); }
        asm volatile("s_waitcnt lgkmcnt(0)" ::: "memory");
        float a16[16];
#pragma unroll
        for (int r = 0; r < 16; ++r) a16[r] = 0.f;
        const float* wp = F.ada_w + (size_t)kw0 * 3072 + 64 * F.bid + F.lane;
#pragma unroll 8
        for (int kk = 0; kk < 128; ++kk) { const float wv = wp[(size_t)kk * 3072];
#pragma unroll
            for (int r = 0; r < 16; ++r) a16[r] += sv[r * 128 + kk] * wv; }
#pragma unroll
        for (int r = 0; r < 16; ++r) red[r * 64 + F.lane] = a16[r];
        __syncthreads();
        for (int o = F.tid; o < 1024; o += NTHR) { const int r = o >> 6, col = o & 63; float s = F.ada_b[64 * F.bid + col];
#pragma unroll
            for (int w = 0; w < 8; ++w) s += *((LAS float*)(lds + w * 16384 + 12288) + r * 64 + col);
            F.mod[r * 3072 + 64 * F.bid + col] = s; }
    }
    const int gw = F.bid * NWAVES + F.wave, NGW = F.G * NWAVES;
    constexpr int I_FOLD = 512, I_IN = 16 * 160, I_OUT = 32 * 32;
    for (int it = gw; it < I_FOLD + I_IN + I_OUT; it += NGW) {
        int r = it;
        if (r < I_FOLD) { p0_fold_item(F, r, scr, F.lane); continue; } r -= I_FOLD;
        if (r < I_IN) { const int kb = r / 160, nb = r % 160, rho0 = 1024 + 32 * nb; p0_transpose_item(F.w_in, DIN, 64 * kb, colmap(rho0), F.WinT, DM, rho0, scr, F.lane); continue; } r -= I_IN;
        { const int kb = r >> 5, nb = r & 31; p0_transpose_item(F.w_out, DM, 64 * kb, 32 * nb, F.WoutT, DMIX, 32 * nb, scr, F.lane); }
    }
}

__device__ __forceinline__ void p1_prenorm(const Ctx& F) {
    const int gw = F.bid * NWAVES + F.wave, NGW = F.G * NWAVES;
    for (int gi = gw; gi < T_ALL / 16; gi += NGW) {
        const int m0 = gi * 16; int b16, pos; row_info(m0, b16, pos);
        const float* md = F.mod + b16 * 3072;
        f32x4 ga[4], sh[4];
#pragma unroll
        for (int j = 0; j < 4; ++j) { const int c = 4 * F.lane + 256 * j; const f32x4 g = *(const f32x4*)(F.g_pre + c), sc = *(const f32x4*)(md + 1024 + c);
            ga[j] = g * (sc + 1.0f); sh[j] = *(const f32x4*)(md + c); }
        for (int r = 0; r < 16; ++r) {
            const f32x4* xr = (const f32x4*)x_row(F, m0 + r) + F.lane;
            f32x4 v[4]; float s = 0.f;
#pragma unroll
            for (int j = 0; j < 4; ++j) { v[j] = xr[64 * j]; s += (v[j].x * v[j].x + v[j].y * v[j].y) + (v[j].z * v[j].z + v[j].w * v[j].w); }
            const float rstd = rsqrtf(wave_sum(s) * (1.f / DM) + EPS);
            u32x2* o8 = (u32x2*)(F.H + (size_t)(m0 + r) * DM) + F.lane;
#pragma unroll
            for (int j = 0; j < 4; ++j) { const f32x4 y = v[j] * rstd * ga[j] + sh[j]; u32x2 w; w.x = pk_bf16(y.x, y.y); w.y = pk_bf16(y.z, y.w); o8[64 * j] = w; }
        }
    }
}

struct SchedIn {
    const char* H; const char* W; int G, c;
    __device__ __forceinline__ bool next(int i, pg8::Unit& u) const {
        int pm, pn; if (!pg8::order_next(i, G, c, T_ALL / 256, DIN / 256, pm, pn)) return false;
        const size_t tstep = (size_t)256 * DM * 2; const char* hp = H + (size_t)pm * tstep; const char* wp = W + (size_t)pn * tstep;
        const bool sw = (pn >= 12 && pn < 16);
        u.a = sw ? wp : hp; u.b = sw ? hp : wp; u.pm = pm; u.pn = pn; return true;
    }
};
struct EpiIn {
    bf16_t *U, *Q, *Kb, *VT, *Z;
    __device__ __forceinline__ void operator()(const f32x4 (&acc)[2][2][4][2], const pg8::Unit& u, int wr, int wc, int fr, int fq) const {
        const int pm = u.pm, pn = u.pn;
        if (pn < 4) {
#pragma unroll
            for (int ai = 0; ai < 2; ++ai)
#pragma unroll
                for (int m = 0; m < 4; ++m) { bf16_t* rp = U + (size_t)(pm * 256 + ai * 128 + wr * 64 + m * 16 + fr) * DM + pn * 256 + wc * 32 + 8 * fq;
#pragma unroll
                    for (int bj = 0; bj < 2; ++bj) { const f32x4 v0 = acc[ai][bj][m][0], v1 = acc[ai][bj][m][1];
                        u32x4 w; w.x = pk_bf16(v0[0], v0[1]); w.y = pk_bf16(v0[2], v0[3]); w.z = pk_bf16(v1[0], v1[1]); w.w = pk_bf16(v1[2], v1[3]);
                        *(u32x4*)(rp + bj * 128) = w; } }
        } else if (pn < 12) {
            const bool isk = pn >= 8; bf16_t* base = isk ? Kb : Q; const float scl = isk ? 0.08838834764831845f : 1.0f;
            const int head = 2 * (pn & 3) + (wc >> 1), dlo = 32 * (wc & 1) + 8 * fq;
            const int pos0 = pm < 256 ? (pm & 31) * 256 : ((pm - 256) & 15) * 256;
            float cf[8];
#pragma unroll
            for (int e = 0; e < 8; ++e) cf[e] = __builtin_amdgcn_exp2f(-(float)(dlo + e) * 0.20762050593046014f) * 0.15915494309189535f;
#pragma unroll
            for (int ai = 0; ai < 2; ++ai)
#pragma unroll
                for (int m = 0; m < 4; ++m) {
                    const int rl = ai * 128 + wr * 64 + m * 16 + fr; const float fpos = (float)(pos0 + rl);
                    float o1[8], o2[8];
#pragma unroll
                    for (int e = 0; e < 8; ++e) {
                        const float rev = fpos * cf[e]; const float fr_ = __builtin_amdgcn_fractf(rev);
                        const float sn = __builtin_amdgcn_sinf(fr_), cs = __builtin_amdgcn_cosf(fr_);
                        const float x1 = acc[ai][0][m][e >> 2][e & 3], x2 = acc[ai][1][m][e >> 2][e & 3];
                        o1[e] = (x1 * cs - x2 * sn) * scl; o2[e] = (x2 * cs + x1 * sn) * scl;
                    }
                    bf16_t* rp = base + (size_t)(pm * 256 + rl) * DM + head * 128 + dlo;
                    u32x4 w1, w2; w1.x = pk_bf16(o1[0], o1[1]); w1.y = pk_bf16(o1[2], o1[3]); w1.z = pk_bf16(o1[4], o1[5]); w1.w = pk_bf16(o1[6], o1[7]);
                    w2.x = pk_bf16(o2[0], o2[1]); w2.y = pk_bf16(o2[2], o2[3]); w2.z = pk_bf16(o2[4], o2[5]); w2.w = pk_bf16(o2[6], o2[7]);
                    *(u32x4*)rp = w1; *(u32x4*)(rp + 64) = w2;
                }
        } else if (pn < 16) {
            int b, t0, S; size_t gbase;
            if (pm < 256) { b = pm >> 5; t0 = (pm & 31) * 256; S = S_P; gbase = 0; } else { const int q = pm - 256; b = q >> 4; t0 = (q & 15) * 256; S = S_S; gbase = (size_t)64 * 128 * S_P; }
#pragma unroll
            for (int ai = 0; ai < 2; ++ai)
#pragma unroll
                for (int m = 0; m < 4; ++m) { const int head = 2 * (pn - 12) + ai, dv = wr * 64 + m * 16 + fr;
                    bf16_t* rp = VT + gbase + ((size_t)(b * 8 + head) * 128 + dv) * S + t0 + wc * 32 + 8 * fq;
#pragma unroll
                    for (int bj = 0; bj < 2; ++bj) { const f32x4 v0 = acc[ai][bj][m][0], v1 = acc[ai][bj][m][1];
                        u32x4 w; w.x = pk_bf16(v0[0], v0[1]); w.y = pk_bf16(v0[2], v0[3]); w.z = pk_bf16(v1[0], v1[1]); w.w = pk_bf16(v1[2], v1[3]);
                        *(u32x4*)(rp + bj * 128) = w; } }
        } else {
#pragma unroll
            for (int ai = 0; ai < 2; ++ai)
#pragma unroll
                for (int m = 0; m < 4; ++m) { bf16_t* rp = Z + (size_t)(pm * 256 + ai * 128 + wr * 64 + m * 16 + fr) * DMIX + (pn - 16) * 256 + wc * 32 + 8 * fq;
#pragma unroll
                    for (int bj = 0; bj < 2; ++bj) { const f32x4 v0 = acc[ai][bj][m][0], v1 = acc[ai][bj][m][1];
                        u32x4 w; w.x = pk_bf16(silu_f(v0[0]), silu_f(v0[1])); w.y = pk_bf16(silu_f(v0[2]), silu_f(v0[3])); w.z = pk_bf16(silu_f(v1[0]), silu_f(v1[1])); w.w = pk_bf16(silu_f(v1[2]), silu_f(v1[3]));
                        *(u32x4*)(rp + bj * 128) = w; } }
        }
    }
};

struct RItem { int S, m0, h, nsc, sc; const bf16_t* vt; };
__device__ __forceinline__ RItem ritem(const Ctx& F, int it) {
    RItem r;
    if (it < 2048) { const int bh = it >> 5; r.sc = it & 31; r.S = S_P; r.nsc = 32; r.h = bh & 7; r.m0 = (bh >> 3) * S_P + r.sc * 256; r.vt = F.VT + (size_t)bh * 128 * S_P + r.sc * 256; }
    else { const int q = it - 2048, bh = q >> 4; r.sc = q & 15; r.S = S_S; r.nsc = 16; r.h = bh & 7; r.m0 = T_P + (bh >> 3) * S_S + r.sc * 256; r.vt = F.VT + (size_t)64 * 128 * S_P + (size_t)bh * 128 * S_S + r.sc * 256; }
    return r;
}
__device__ __forceinline__ float log2_gamma(const float* dec, int h) { return log1pf(-exp2f(-dec[h])) * 1.4426950408889634f; }

__device__ __forceinline__ void ra_item(const Ctx& F, int it, LAS unsigned char* lds) {
    const RItem R = ritem(F, it);
    const int tid = F.tid, w = F.wave, lane = F.lane, l15 = lane & 15, g = lane >> 4;
    LAS unsigned char* Kl = lds;
    LAS unsigned char* Vl = lds + 69632;
#pragma unroll
    for (int p = 0; p < 8; ++p) { const int idx = p * NTHR + tid, row = idx >> 4, c = idx & 15;
        const u32x4 v = *(const u32x4*)(F.Kb + (size_t)(R.m0 + row) * DM + R.h * 128 + c * 8);
        LAS u32x2* d = (LAS u32x2*)(Kl + row * 264 + c * 16); d[0] = (u32x2){v.x, v.y}; d[1] = (u32x2){v.z, v.w}; }
#pragma unroll
    for (int p = 0; p < 8; ++p) { const int idx = p * NTHR + tid, row = idx >> 5, c = idx & 31;
        const u32x4 v = *(const u32x4*)(R.vt + (size_t)row * R.S + c * 8);
        *(LAS u32x4*)(Vl + row * 528 + c * 16) = v; }
    __syncthreads();
    const int dir = w >> 2, dk0 = (w & 3) * 32;
    const float lg2 = log2_gamma(dir ? F.dec_b : F.dec_f, R.h);
    f32x4 acc[2][8];
#pragma unroll
    for (int mt = 0; mt < 2; ++mt)
#pragma unroll
        for (int nt = 0; nt < 8; ++nt) acc[mt][nt] = (f32x4){0.f, 0.f, 0.f, 0.f};
    const LAS bf16_t* Ks = (const LAS bf16_t*)Kl;
#pragma unroll 2
    for (int kk = 0; kk < 8; ++kk) {
        float wj[8];
#pragma unroll
        for (int e = 0; e < 8; ++e) { const int j = 32 * kk + 8 * g + e; wj[e] = __builtin_amdgcn_exp2f(lg2 * (float)(dir ? j : 255 - j)); }
        bf16x8 af[2];
#pragma unroll
        for (int mt = 0; mt < 2; ++mt) { const int dk = dk0 + 16 * mt + l15; float t[8];
#pragma unroll
            for (int e = 0; e < 8; ++e) t[e] = __uint_as_float((unsigned)Ks[(32 * kk + 8 * g + e) * 132 + dk] << 16) * wj[e];
            u32x4 pa; pa.x = pk_bf16(t[0], t[1]); pa.y = pk_bf16(t[2], t[3]); pa.z = pk_bf16(t[4], t[5]); pa.w = pk_bf16(t[6], t[7]);
            af[mt] = __builtin_bit_cast(bf16x8, pa); }
#pragma unroll
        for (int nt = 0; nt < 8; ++nt) { const bf16x8 bfr = *(const LAS bf16x8*)(Vl + (16 * nt + l15) * 528 + (32 * kk + 8 * g) * 2);
#pragma unroll
            for (int mt = 0; mt < 2; ++mt) acc[mt][nt] = __builtin_amdgcn_mfma_f32_16x16x32_bf16(af[mt], bfr, acc[mt][nt], 0, 0, 0); }
    }
    bf16_t* kv = F.KV + (size_t)it * 32768 + dir * 16384;
#pragma unroll
    for (int mt = 0; mt < 2; ++mt)
#pragma unroll
        for (int nt = 0; nt < 8; ++nt) { const f32x4 v = acc[mt][nt]; u32x2 o; o.x = pk_bf16(v[0], v[1]); o.y = pk_bf16(v[2], v[3]);
            *(u32x2*)(kv + (16 * nt + l15) * 128 + dk0 + 16 * mt + 4 * g) = o; }
    __syncthreads();
}

__device__ __forceinline__ void acc8(float (&s)[8], const u32x4 v, float sg) {
    s[0] += sg * bf_lo(v.x); s[1] += sg * bf_hi(v.x); s[2] += sg * bf_lo(v.y); s[3] += sg * bf_hi(v.y); s[4] += sg * bf_lo(v.z); s[5] += sg * bf_hi(v.z); s[6] += sg * bf_lo(v.w); s[7] += sg * bf_hi(v.w);
}
__device__ __forceinline__ void pool_item(const Ctx& F, int pt, LAS unsigned char* lds) {
    const int tid = F.tid, cg8 = tid & 127, tq = tid >> 7, ch = 8 * cg8, half = 1 << (cg8 >> 5);
    const int m0 = pt * 32; int b16, pos0; row_info(m0, b16, pos0);
    const int S = m0 < T_P ? S_P : S_S; const int mseq = m0 - pos0;
    const bf16_t* ub = F.U + (size_t)mseq * DM;
    u32x4 stg[12];
#pragma unroll
    for (int p = 0; p < 12; ++p) { const int idx = p * NTHR + tid, row = idx >> 7, c = idx & 127, pos = pos0 - 8 + row;
        stg[p] = (pos >= 0 && pos < S) ? *(const u32x4*)(ub + (size_t)pos * DM + c * 8) : (u32x4){0u, 0u, 0u, 0u}; }
    bf16_t* zp = F.Z + (size_t)(m0 + 8 * tq) * DMIX + ch;
    u32x4 zv[8];
#pragma unroll
    for (int r = 0; r < 8; ++r) zv[r] = *(const u32x4*)(zp + (size_t)r * DMIX);
#pragma unroll
    for (int p = 0; p < 12; ++p) { const int idx = p * NTHR + tid; *(LAS u32x4*)(lds + (idx >> 7) * 2048 + (idx & 127) * 16) = stg[p]; }
    __syncthreads();
    float ps[8];
    { const f32x4 a = *(const f32x4*)(F.pool_scale + ch), b = *(const f32x4*)(F.pool_scale + ch + 4); ps[0] = a.x; ps[1] = a.y; ps[2] = a.z; ps[3] = a.w; ps[4] = b.x; ps[5] = b.y; ps[6] = b.z; ps[7] = b.w; }
    const LAS unsigned char* col = lds + cg8 * 16;
    const int t0 = 8 * tq;
    float sum[8];
#pragma unroll
    for (int e = 0; e < 8; ++e) sum[e] = 0.f;
    for (int s2 = 0; s2 < 2 * half; ++s2) acc8(sum, *(const LAS u32x4*)(col + (t0 + 8 - half + s2) * 2048), 1.0f);
#pragma unroll
    for (int r = 0; r < 8; ++r) {
        const int t = t0 + r, pos = pos0 + t;
        if (r > 0) { acc8(sum, *(const LAS u32x4*)(col + (t + 7 + half) * 2048), 1.0f); acc8(sum, *(const LAS u32x4*)(col + (t + 7 - half) * 2048), -1.0f); }
        const int lo = max(pos - half, 0), hi = min(pos + half, S); const float inv = 1.0f / (float)(hi - lo);
        const u32x4 c = *(const LAS u32x4*)(col + (t + 8) * 2048), z = zv[r];
        float y[8];
        y[0] = (sum[0] * inv - bf_lo(c.x)) * ps[0] * bf_lo(z.x); y[1] = (sum[1] * inv - bf_hi(c.x)) * ps[1] * bf_hi(z.x);
        y[2] = (sum[2] * inv - bf_lo(c.y)) * ps[2] * bf_lo(z.y); y[3] = (sum[3] * inv - bf_hi(c.y)) * ps[3] * bf_hi(z.y);
        y[4] = (sum[4] * inv - bf_lo(c.z)) * ps[4] * bf_lo(z.z); y[5] = (sum[5] * inv - bf_hi(c.z)) * ps[5] * bf_hi(z.z);
        y[6] = (sum[6] * inv - bf_lo(c.w)) * ps[6] * bf_lo(z.w); y[7] = (sum[7] * inv - bf_hi(c.w)) * ps[7] * bf_hi(z.w);
        u32x4 o; o.x = pk_bf16(y[0], y[1]); o.y = pk_bf16(y[2], y[3]); o.z = pk_bf16(y[4], y[5]); o.w = pk_bf16(y[6], y[7]);
        *(u32x4*)(zp + (size_t)r * DMIX) = o;
    }
    __syncthreads();
}

__device__ __forceinline__ void rb_scan(const Ctx& F) {
    for (int q = F.bid; q < 1024; q += F.G) {
        const int seq = q >> 3, dir = (q >> 2) & 1, quarter = q & 3;
        const int nsc = seq < 64 ? 32 : 16, it0 = seq < 64 ? seq * 32 : 2048 + (seq - 64) * 16, h = seq & 7;
        const float Gd = __builtin_amdgcn_exp2f(256.0f * log2_gamma(dir ? F.dec_b : F.dec_f, h));
        bf16_t* base = F.KV + (size_t)it0 * 32768 + dir * 16384 + quarter * 4096 + F.tid * 8;
        float st[8];
#pragma unroll
        for (int e = 0; e < 8; ++e) st[e] = 0.f;
        for (int s0 = 0; s0 < nsc; s0 += 4) {
            u32x4 v[4];
#pragma unroll
            for (int u = 0; u < 4; ++u) { const int sc = dir ? nsc - 1 - (s0 + u) : s0 + u; v[u] = *(const u32x4*)(base + (size_t)sc * 32768); }
#pragma unroll
            for (int u = 0; u < 4; ++u) { const int sc = dir ? nsc - 1 - (s0 + u) : s0 + u;
                u32x4 o; o.x = pk_bf16(st[0], st[1]); o.y = pk_bf16(st[2], st[3]); o.z = pk_bf16(st[4], st[5]); o.w = pk_bf16(st[6], st[7]);
                *(u32x4*)(base + (size_t)sc * 32768) = o;
                st[0] = st[0] * Gd + bf_lo(v[u].x); st[1] = st[1] * Gd + bf_hi(v[u].x); st[2] = st[2] * Gd + bf_lo(v[u].y); st[3] = st[3] * Gd + bf_hi(v[u].y);
                st[4] = st[4] * Gd + bf_lo(v[u].z); st[5] = st[5] * Gd + bf_hi(v[u].z); st[6] = st[6] * Gd + bf_lo(v[u].w); st[7] = st[7] * Gd + bf_hi(v[u].w); }
        }
    }
}

__device__ __forceinline__ unsigned rc_voff(int lane, int v, unsigned pitch) { const int rsub = lane >> 4, cpos = lane & 15; return (unsigned)rsub * pitch + (unsigned)((cpos ^ (4 * v + rsub)) << 4); }
__device__ __forceinline__ void rc_issue_A(const Ctx& F, const RItem& R, int h2, LAS unsigned char* buf, int w, int lane) {
    const bool isk = w < 4; const unsigned pitch = isk ? 2048u : 2u * (unsigned)R.S;
    const char* ub = isk ? (const char*)(F.Kb + (size_t)(R.m0 + 128 * h2) * DM + R.h * 128) : (const char*)(R.vt + 128 * h2);
    LAS unsigned char* lb = buf + (isk ? 0 : 32768) + (w & 3) * 8192;
    unsigned vo[4];
#pragma unroll
    for (int v = 0; v < 4; ++v) vo[v] = rc_voff(lane, v, pitch);
#pragma unroll
    for (int i = 0; i < 8; ++i) {
        const int qq = 8 * (w & 3) + i;
        __builtin_amdgcn_global_load_lds((const unsigned*)(ub + (size_t)(4 * qq) * pitch + vo[i & 3]), (LAS unsigned*)(lb + i * 1024), 16, 0, 0);
    }
}
__device__ __forceinline__ void rc_issue_B(const Ctx& F, int it, LAS unsigned char* buf, int w, int lane) {
    const char* ub = (const char*)(F.KV + (size_t)it * 32768) + w * 8192;
    LAS unsigned char* lb = buf + w * 8192;
    unsigned vo[4];
#pragma unroll
    for (int v = 0; v < 4; ++v) vo[v] = rc_voff(lane, v, 256u);
#pragma unroll
    for (int i = 0; i < 8; ++i)
        __builtin_amdgcn_global_load_lds((const unsigned*)(ub + i * 1024 + vo[i & 3]), (LAS unsigned*)(lb + i * 1024), 16, 0, 0);
}
__device__ __forceinline__ void rc_load_q(const Ctx& F, const RItem& R, int w, int l15, int g, bf16x8 (&qf)[2][4]) {
#pragma unroll
    for (int n2 = 0; n2 < 2; ++n2)
#pragma unroll
        for (int kk = 0; kk < 4; ++kk) qf[n2][kk] = *(const bf16x8*)(F.Q + (size_t)(R.m0 + 32 * w + 16 * n2 + l15) * DM + R.h * 128 + 32 * kk + 8 * g);
}
__device__ __forceinline__ void rc_half(const LAS unsigned char* buf, const LAS float* tab, int h2, const bf16x8 (&qf)[2][4], f32x4 (&o)[8][2],
                                        const float (&fa)[2], const float (&ba)[2], const int (&irow)[2], int l15, int g) {
#pragma unroll 1
    for (int k2 = 0; k2 < 4; ++k2) {
        f32x4 s[2][2];
#pragma unroll
        for (int jj = 0; jj < 2; ++jj)
#pragma unroll
            for (int n2 = 0; n2 < 2; ++n2) s[jj][n2] = (f32x4){0.f, 0.f, 0.f, 0.f};
#pragma unroll
        for (int jj = 0; jj < 2; ++jj)
#pragma unroll
            for (int kk = 0; kk < 4; ++kk) { const bf16x8 a = *(const LAS bf16x8*)(buf + (16 * (2 * k2 + jj) + l15) * 256 + (((4 * kk + g) ^ l15) << 4));
#pragma unroll
                for (int n2 = 0; n2 < 2; ++n2) s[jj][n2] = __builtin_amdgcn_mfma_f32_16x16x32_bf16(a, qf[n2][kk], s[jj][n2], 0, 0, 0); }
        const int jb = 128 * h2 + 32 * k2 + 4 * g;
        f32x4 tf[2], tb[2];
#pragma unroll
        for (int jj = 0; jj < 2; ++jj) { tf[jj] = *(const LAS f32x4*)(tab + jb + 16 * jj); tb[jj] = *(const LAS f32x4*)(tab + 256 + jb + 16 * jj); }
        bf16x8 pf[2];
#pragma unroll
        for (int n2 = 0; n2 < 2; ++n2) { float p[8];
#pragma unroll
            for (int jj = 0; jj < 2; ++jj)
#pragma unroll
                for (int r = 0; r < 4; ++r) { const int j = jb + 16 * jj + r; const float d = (j <= irow[n2]) ? fa[n2] * tf[jj][r] : ba[n2] * tb[jj][r]; p[4 * jj + r] = s[jj][n2][r] * d; }
            u32x4 pp; pp.x = pk_bf16(p[0], p[1]); pp.y = pk_bf16(p[2], p[3]); pp.z = pk_bf16(p[4], p[5]); pp.w = pk_bf16(p[6], p[7]);
            pf[n2] = __builtin_bit_cast(bf16x8, pp); }
#pragma unroll
        for (int mt = 0; mt < 8; ++mt) { const LAS unsigned char* vp = buf + 32768 + (16 * mt + l15) * 256 + 8 * (g & 1); const int c0 = 4 * k2 + (g >> 1);
            const u32x2 lo = *(const LAS u32x2*)(vp + ((c0 ^ l15) << 4)), hi = *(const LAS u32x2*)(vp + (((c0 + 2) ^ l15) << 4));
            const bf16x8 a = __builtin_bit_cast(bf16x8, (u32x4){lo.x, lo.y, hi.x, hi.y});
#pragma unroll
            for (int n2 = 0; n2 < 2; ++n2) o[mt][n2] = __builtin_amdgcn_mfma_f32_16x16x32_bf16(a, pf[n2], o[mt][n2], 0, 0, 0);
            if (mt & 1) __builtin_amdgcn_sched_barrier(0); }
    }
}
#define RC_WAIT_BAR() do { asm volatile("s_waitcnt vmcnt(0)" ::: "memory"); __syncthreads(); } while (0)
__device__ __forceinline__ void rc_phase(const Ctx& F, LAS unsigned char* lds) {
    const int tid = F.tid, w = F.wave;
    const int nitems = (3072 - F.bid + F.G - 1) / F.G;
    if (nitems <= 0) return;
    LAS float* tabs = (LAS float*)(lds + 131072);
    RItem R = ritem(F, F.bid);
    bf16x8 qf[2][4];
    rc_issue_A(F, R, 0, lds, w, F.lane);
    rc_load_q(F, R, w, F.lane & 15, F.lane >> 4, qf);
    for (int n = 0; n < nitems; ++n) {
        int lane_o = F.lane; asm volatile("" : "+v"(lane_o));
        const int lane = lane_o, l15 = lane & 15, g = lane >> 4;
        const int it = F.bid + n * F.G, par = n & 1;
        LAS unsigned char* b0 = lds + par * 65536; LAS unsigned char* b1 = lds + (par ^ 1) * 65536;
        LAS float* tab = tabs + par * 512;
        const float lg2f = log2_gamma(F.dec_f, R.h), lg2b = log2_gamma(F.dec_b, R.h);
        tab[tid] = tid < 256 ? __builtin_amdgcn_exp2f(-lg2f * (float)tid) : __builtin_amdgcn_exp2f(lg2b * (float)(tid - 256));
        float fa[2], ba[2]; int irow[2];
#pragma unroll
        for (int n2 = 0; n2 < 2; ++n2) { irow[n2] = 32 * w + 16 * n2 + l15; fa[n2] = __builtin_amdgcn_exp2f(lg2f * (float)irow[n2]); ba[n2] = __builtin_amdgcn_exp2f(-lg2b * (float)irow[n2]); }
        f32x4 o[8][2];
#pragma unroll
        for (int mt = 0; mt < 8; ++mt)
#pragma unroll
            for (int n2 = 0; n2 < 2; ++n2) o[mt][n2] = (f32x4){0.f, 0.f, 0.f, 0.f};
        RC_WAIT_BAR();
        rc_issue_A(F, R, 1, b1, w, lane);
        rc_half(b0, tab, 0, qf, o, fa, ba, irow, l15, g);
        RC_WAIT_BAR();
        rc_issue_B(F, it, b0, w, lane);
        rc_half(b1, tab, 1, qf, o, fa, ba, irow, l15, g);
        RC_WAIT_BAR();
        const bool more = (n + 1 < nitems);
        RItem Rn = R;
        if (more) { Rn = ritem(F, it + F.G); rc_issue_A(F, Rn, 0, b1, w, lane); }
        {
            float qfd[2], qbd[2];
#pragma unroll
            for (int n2 = 0; n2 < 2; ++n2) { qfd[n2] = __builtin_amdgcn_exp2f(lg2f * (float)(irow[n2] + 1)); qbd[n2] = __builtin_amdgcn_exp2f(lg2b * (float)(256 - irow[n2])); }
#pragma unroll
            for (int mt = 0; mt < 8; ++mt) {
                f32x4 tf[2], tb[2];
#pragma unroll
                for (int n2 = 0; n2 < 2; ++n2) { tf[n2] = (f32x4){0.f, 0.f, 0.f, 0.f}; tb[n2] = (f32x4){0.f, 0.f, 0.f, 0.f}; }
#pragma unroll
                for (int kk = 0; kk < 4; ++kk) { const LAS unsigned char* sp = b0 + (16 * mt + l15) * 256 + (((4 * kk + g) ^ l15) << 4);
                    const bf16x8 af = *(const LAS bf16x8*)sp, ab = *(const LAS bf16x8*)(sp + 32768);
#pragma unroll
                    for (int n2 = 0; n2 < 2; ++n2) { tf[n2] = __builtin_amdgcn_mfma_f32_16x16x32_bf16(af, qf[n2][kk], tf[n2], 0, 0, 0); tb[n2] = __builtin_amdgcn_mfma_f32_16x16x32_bf16(ab, qf[n2][kk], tb[n2], 0, 0, 0); } }
#pragma unroll
                for (int n2 = 0; n2 < 2; ++n2) o[mt][n2] += tf[n2] * qfd[n2] + tb[n2] * qbd[n2];
                __builtin_amdgcn_sched_barrier(0);
            }
        }
        bf16_t* zbase = F.Z + (size_t)(R.m0 + 32 * w + l15) * DMIX + 1024 + R.h * 128 + 4 * g;
        if (more) { R = Rn; rc_load_q(F, R, w, l15, g, qf); }
#pragma unroll
        for (int n2 = 0; n2 < 2; ++n2) {
            float s1 = 0.f;
#pragma unroll
            for (int mt = 0; mt < 8; ++mt) s1 += (o[mt][n2][0] + o[mt][n2][1]) + (o[mt][n2][2] + o[mt][n2][3]);
            s1 += __shfl_xor(s1, 16); s1 += __shfl_xor(s1, 32);
            const float mu = s1 * (1.0f / 128.0f); float s2 = 0.f;
#pragma unroll
            for (int mt = 0; mt < 8; ++mt) { const f32x4 d = o[mt][n2] - mu; s2 += (d[0] * d[0] + d[1] * d[1]) + (d[2] * d[2] + d[3] * d[3]); }
            s2 += __shfl_xor(s2, 16); s2 += __shfl_xor(s2, 32);
            const float rs = rsqrtf(s2 * (1.0f / 128.0f) + EPS);
            bf16_t* zp = zbase + (size_t)(16 * n2) * DMIX;
#pragma unroll
            for (int mt = 0; mt < 8; ++mt) { const u32x2 z = *(const u32x2*)(zp + 16 * mt); const f32x4 d = (o[mt][n2] - mu) * rs;
                u32x2 ov; ov.x = pk_bf16(d[0] * bf_lo(z.x), d[1] * bf_hi(z.x)); ov.y = pk_bf16(d[2] * bf_lo(z.y), d[3] * bf_hi(z.y));
                *(u32x2*)(zp + 16 * mt) = ov; }
        }
    }
    RC_WAIT_BAR();
}

struct SchedOut {
    const char* Y; const char* W; int G, c;
    __device__ __forceinline__ bool next(int i, pg8::Unit& u) const {
        int pm, pn; if (!pg8::order_next(i, G, c, T_ALL / 256, DM / 256, pm, pn)) return false;
        const size_t tstep = (size_t)256 * DMIX * 2; u.a = Y + (size_t)pm * tstep; u.b = W + (size_t)pn * tstep; u.pm = pm; u.pn = pn; return true;
    }
};
struct EpiOut {
    bf16_t* O; float* part;
    __device__ __forceinline__ void operator()(const f32x4 (&acc)[2][2][4][2], const pg8::Unit& u, int wr, int wc, int fr, int fq) const {
#pragma unroll
        for (int ai = 0; ai < 2; ++ai)
#pragma unroll
            for (int m = 0; m < 4; ++m) { const size_t row = (size_t)(u.pm * 256 + ai * 128 + wr * 64 + m * 16 + fr); bf16_t* rp = O + row * DM + u.pn * 256 + wc * 32 + 8 * fq; float ss = 0.f;
#pragma unroll
                for (int bj = 0; bj < 2; ++bj) { const f32x4 v0 = acc[ai][bj][m][0], v1 = acc[ai][bj][m][1];
                    ss += (v0[0] * v0[0] + v0[1] * v0[1]) + (v0[2] * v0[2] + v0[3] * v0[3]) + (v1[0] * v1[0] + v1[1] * v1[1]) + (v1[2] * v1[2] + v1[3] * v1[3]);
                    u32x4 w; w.x = pk_bf16(v0[0], v0[1]); w.y = pk_bf16(v0[2], v0[3]); w.z = pk_bf16(v1[0], v1[1]); w.w = pk_bf16(v1[2], v1[3]);
                    *(u32x4*)(rp + bj * 128) = w; }
                ss += __shfl_xor(ss, 16); ss += __shfl_xor(ss, 32);
                if (fq == 0) part[row * 16 + u.pn * 4 + wc] = ss; }
    }
};

__device__ __forceinline__ void p7_final(const Ctx& F) {
    const int gw = F.bid * NWAVES + F.wave, NGW = F.G * NWAVES;
    for (int gi = gw; gi < T_ALL / 16; gi += NGW) {
        const int m0 = gi * 16; int b16, pos; row_info(m0, b16, pos);
        const float* md = F.mod + b16 * 3072 + 2048;
        f32x4 gg[4];
#pragma unroll
        for (int j = 0; j < 4; ++j) { const int c = 4 * F.lane + 256 * j; gg[j] = *(const f32x4*)(F.g_post + c) * *(const f32x4*)(md + c); }
        for (int r = 0; r < 16; ++r) {
            const int m = m0 + r;
            float ss = F.part[(size_t)m * 16 + (F.lane & 15)];
            ss += __shfl_xor(ss, 1); ss += __shfl_xor(ss, 2); ss += __shfl_xor(ss, 4); ss += __shfl_xor(ss, 8);
            const float rstd = rsqrtf(ss * (1.f / DM) + EPS);
            const f32x4* xr = (const f32x4*)x_row(F, m) + F.lane;
            const u32x2* orow = (const u32x2*)(F.OUTB + (size_t)m * DM) + F.lane;
            f32x4* dst = (f32x4*)(F.out + (size_t)m * DM) + F.lane;
#pragma unroll
            for (int j = 0; j < 4; ++j) { const u32x2 ov = orow[64 * j]; const f32x4 xv = xr[64 * j];
                f32x4 y; y.x = xv.x + gg[j].x * (bf_lo(ov.x) * rstd); y.y = xv.y + gg[j].y * (bf_hi(ov.x) * rstd); y.z = xv.z + gg[j].z * (bf_lo(ov.y) * rstd); y.w = xv.w + gg[j].w * (bf_hi(ov.y) * rstd);
                dst[64 * j] = y; }
        }
    }
}

#ifndef PROBE_DUP
#define PROBE_DUP 0
#endif
__global__ void __launch_bounds__(NTHR, 2) fwd_megakernel(Args args) {
    extern __shared__ __attribute__((aligned(16))) unsigned char smem[];
    cg::grid_group grid = cg::this_grid();
    LAS unsigned char* lds = (LAS unsigned char*)smem;
    Ctx F;
    F.xp = args.in[0]; F.xs = args.in[1]; F.cp = args.in[2]; F.cs = args.in[3]; F.ada_w = args.in[4]; F.ada_b = args.in[5]; F.g_pre = args.in[6]; F.g_post = args.in[7];
    F.w_in = args.in[8]; F.pool_w = args.in[9]; F.pool_scale = args.in[10]; F.dec_f = args.in[11]; F.dec_b = args.in[12]; F.w_out = args.in[13];
    F.out = args.out; F.ws = args.ws;
    F.mod = (float*)(args.ws + WS_MOD); F.WinT = (bf16_t*)(args.ws + WS_WIN); F.WoutT = (bf16_t*)(args.ws + WS_WOUT); F.part = (float*)(args.ws + WS_PART);
    F.H = (bf16_t*)(args.ws + WS_H); F.U = (bf16_t*)(args.ws + WS_U); F.Q = (bf16_t*)(args.ws + WS_Q); F.Kb = (bf16_t*)(args.ws + WS_K); F.VT = (bf16_t*)(args.ws + WS_VT);
    F.Z = (bf16_t*)args.out; F.KV = (bf16_t*)(args.ws + WS_H); F.OUTB = (bf16_t*)(args.ws + WS_U);
    F.tid = threadIdx.x; F.lane = F.tid & 63; F.wave = __builtin_amdgcn_readfirstlane(F.tid >> 6); F.G = gridDim.x; F.bid = blockIdx.x;
    const int lo = args.ph_lo, hi = args.ph_hi;
#define IN(k) (lo <= (k) && (k) < hi)
#define SEAM(k) do { if (IN(k) && IN((k) + 1)) grid.sync(); } while (0)
    if (IN(0)) { p0_prologue(F, lds); if (PROBE_DUP == 10) { __syncthreads(); p0_prologue(F, lds); } } SEAM(0);
    if (IN(1)) { p1_prenorm(F); if (PROBE_DUP == 11) p1_prenorm(F); } SEAM(1);
    if (IN(2)) { for (int rep = 0; rep < (PROBE_DUP == 2 ? 2 : 1); ++rep) { SchedIn S{(const char*)F.H, (const char*)F.WinT, F.G, F.bid}; EpiIn E{F.U, F.Q, F.Kb, F.VT, F.Z}; pg8::gemm_phase<EpiIn, SchedIn>(lds, DM, S, E); } } SEAM(2);
    if (IN(3)) {
        for (int it = F.bid; it < 3072; it += F.G) ra_item(F, it, lds);
        for (int pt = F.bid; pt < T_ALL / 32; pt += F.G) pool_item(F, pt, lds);
    } SEAM(3);
    if (IN(4)) { rb_scan(F); } SEAM(4);
    if (IN(5)) { rc_phase(F, lds); } SEAM(5);
    if (IN(6)) { for (int rep = 0; rep < (PROBE_DUP == 6 ? 2 : 1); ++rep) { SchedOut S{(const char*)F.Z, (const char*)F.WoutT, F.G, F.bid}; EpiOut E{F.OUTB, F.part}; pg8::gemm_phase<EpiOut, SchedOut>(lds, DMIX, S, E); } } SEAM(6);
    if (IN(7)) { p7_final(F); if (PROBE_DUP == 17) p7_final(F); }
}

#ifndef N_LAUNCH_MODE
#define N_LAUNCH_MODE 1
#endif

extern "C" void kernel_launch(void* const* d_in, const int* in_sizes, int n_in, void* d_out, int out_size, void* d_ws, size_t ws_size, hipStream_t stream) {
    static int grid = 0;
    if (grid == 0) {
        if (n_in != 14 || out_size != T_ALL * DM || ws_size < WS_END) { fprintf(stderr, "kernel_launch: unexpected shapes (n_in %d out %d ws %zu)\n", n_in, out_size, ws_size); grid = -1; return; }
        int dev = 0, cus = 0, per_cu = 0;
        hipGetDevice(&dev); hipDeviceGetAttribute(&cus, hipDeviceAttributeMultiprocessorCount, dev);
        if (hipFuncSetAttribute((const void*)fwd_megakernel, hipFuncAttributeMaxDynamicSharedMemorySize, LDS_BYTES) != hipSuccess) { fprintf(stderr, "kernel_launch: hipFuncSetAttribute failed\n"); grid = -1; return; }
        if (hipOccupancyMaxActiveBlocksPerMultiprocessor(&per_cu, (const void*)fwd_megakernel, NTHR, LDS_BYTES) != hipSuccess || per_cu < 1) { fprintf(stderr, "kernel_launch: occupancy query says %d\n", per_cu); per_cu = 1; }
        (void)hipGetLastError();
        grid = cus * per_cu;
        fprintf(stderr, "kernel_launch: cus %d per_cu %d grid %d\n", cus, per_cu, grid);
    }
    if (grid < 0) return;
    Args a{};
    for (int i = 0; i < 14; ++i) a.in[i] = (const float*)d_in[i];
    a.out = (float*)d_out; a.ws = (unsigned char*)d_ws;
#if N_LAUNCH_MODE == 1
    a.ph_lo = 0; a.ph_hi = 8;
    void* kargs[] = {&a};
    hipError_t e = hipLaunchCooperativeKernel((const void*)fwd_megakernel, dim3(grid), dim3(NTHR), kargs, LDS_BYTES, stream);
    if (e != hipSuccess) fprintf(stderr, "kernel_launch: cooperative launch failed: %s (grid %d)\n", hipGetErrorString(e), grid);
#else
    for (int p = 0; p < 8; ++p) { a.ph_lo = p; a.ph_hi = p + 1; hipLaunchKernelGGL(fwd_megakernel, dim3(grid), dim3(NTHR), LDS_BYTES, stream, a); }
#endif
}
```

```cpp
#include <hip/hip_runtime.h>
#include <hip/hip_cooperative_groups.h>
#include <cstdio>
#include <cstdint>
namespace cg = cooperative_groups;

#define LAS __attribute__((address_space(3)))
typedef unsigned short bf16_t;
typedef short bf16x8 __attribute__((ext_vector_type(8)));
typedef float f32x4 __attribute__((ext_vector_type(4)));
typedef unsigned u32x4 __attribute__((ext_vector_type(4)));
typedef unsigned u32x2 __attribute__((ext_vector_type(2)));

constexpr int NTHR = 512, NWAVES = 8;
constexpr int DM = 1024, DIN = 6144, DMIX = 2048;
constexpr int T_P = 65536, T_S = 32768, T_ALL = 98304, S_P = 8192, S_S = 4096;
constexpr float EPS = 1e-6f;
constexpr size_t MiB = 1u << 20;
constexpr size_t WS_MOD = 0;
constexpr size_t WS_BAR = 512 * 1024;
constexpr size_t WS_WIN = 1 * MiB;
constexpr size_t WS_WOUT = 13 * MiB;
constexpr size_t WS_PART = 17 * MiB;
constexpr size_t WS_H = 24 * MiB;
constexpr size_t WS_U = 216 * MiB;
constexpr size_t WS_Q = 408 * MiB;
constexpr size_t WS_K = 600 * MiB;
constexpr size_t WS_VT = 792 * MiB;
constexpr size_t WS_END = 984 * MiB;
constexpr int LDS_BYTES = 147456;

__device__ __forceinline__ unsigned pk_bf16(float lo, float hi) { unsigned r; asm("v_cvt_pk_bf16_f32 %0, %1, %2" : "=v"(r) : "v"(lo), "v"(hi)); return r; }
__device__ __forceinline__ float bf_lo(unsigned u) { return __uint_as_float(u << 16); }
__device__ __forceinline__ float bf_hi(unsigned u) { return __uint_as_float(u & 0xffff0000u); }
__device__ __forceinline__ float wave_sum(float v) {
#pragma unroll
    for (int o = 1; o < 64; o <<= 1) v += __shfl_xor(v, o);
    return v;
}
__device__ __forceinline__ float silu_f(float z) { return z * __builtin_amdgcn_rcpf(1.0f + __builtin_amdgcn_exp2f(-1.4426950408889634f * z)); }
__device__ __forceinline__ void row_info(int m, int& b16, int& pos) { if (m < T_P) { b16 = m >> 13; pos = m & 8191; } else { const int mm = m - T_P; b16 = 8 + (mm >> 12); pos = mm & 4095; } }

namespace pg8 {
constexpr int BM = 256, BK = 64, HALF = 128, HTB = HALF * BK * 2, STAGE_BYTES = 8 * HTB, NXCD = 8, WGM = 8;
__host__ __device__ __forceinline__ int lds_byte(int r, int c) { const int st = (r >> 4) * 2 + (c >> 5), rr = r & 15, cc = c & 31, ob = rr * 64 + cc * 2; return st * 1024 + (ob ^ (((ob >> 9) & 1) << 5)); }
__host__ __device__ __forceinline__ void stage_rc(int b, int& R, int& C) { const int st = b / 1024, sb = b % 1024, swz = sb ^ (((sb >> 9) & 1) << 5); R = (st >> 1) * 16 + swz / 64; C = (st & 1) * 32 + (swz % 64) / 2; }
__host__ __device__ __forceinline__ int perm32(int rho) { const int n = rho >> 4, i = rho & 15; return 8 * (i >> 2) + 4 * n + (i & 3); }

struct Unit { const char* a; const char* b; int pm, pn; };

__device__ __forceinline__ bool order_next(int i, int G, int c, int nM, int nN, int& pm, int& pn) {
    const int nwg = nM * nN; const long L = (long)i * G + c; if (L >= nwg) return false;
    int wgid = (int)L; { const int q = nwg / NXCD, r = nwg % NXCD, xcd = wgid % NXCD, off = wgid / NXCD; wgid = (xcd < r ? xcd * (q + 1) : r * (q + 1) + (xcd - r) * q) + off; }
    const int nig = WGM * nN, gid = wgid / nig, fm = gid * WGM, gsz = (nM - fm) < WGM ? (nM - fm) : WGM;
    pm = fm + ((wgid % nig) % gsz); pn = (wgid % nig) / gsz; return true;
}

template <class Epi, class Sched>
__device__ __forceinline__ void gemm_phase(LAS unsigned char* lds, const int K, const Sched& S, const Epi& E) {
    const int tid = threadIdx.x, wid = __builtin_amdgcn_readfirstlane(tid >> 6), lane = tid & 63, wr = wid >> 2, wc = wid & 3, fr = lane & 15, fq = lane >> 4;
    const int nt = K / BK;
    unsigned voffA[2], voffB[2];
#pragma unroll
    for (int i = 0; i < 2; ++i) { int R, C; stage_rc(tid * 16 + i * 8192, R, C); const int Rb = (R & ~31) + perm32(R & 31);
        voffA[i] = (unsigned)(R * K + C) * 2u; voffB[i] = (unsigned)(Rb * K + C) * 2u; }
    const size_t kstep = (size_t)(BK * 2);
    const size_t hstep = (size_t)HALF * K * 2;
    const unsigned ldsw = (unsigned)wid * 1024u;
    const int aoff = lds_byte(wr * 64 + fr, fq * 8), boff = lds_byte(wc * 32 + fr, fq * 8);
#define PG8_SA(b, h) (((b) * 2 + (h)) * HTB)
#define PG8_SB(b, h) ((4 + (b) * 2 + (h)) * HTB)
#define PG8_STAGE(bufoff, gbase, voff) do { _Pragma("unroll") for (int _i = 0; _i < 2; ++_i) \
        __builtin_amdgcn_global_load_lds((const unsigned*)((const char*)(gbase) + (voff)[_i]), (LAS unsigned*)(lds + (bufoff) + ldsw + _i * 8192), 16, 0, 0); } while (0)
#define PG8_LDA(dst, b, h) do { _Pragma("unroll") for (int m = 0; m < 4; ++m) _Pragma("unroll") for (int k = 0; k < 2; ++k) dst[m][k] = *(const LAS bf16x8*)(lds + PG8_SA(b, h) + aoff + m * 2048 + k * 1024); } while (0)
#define PG8_LDB(dst, b, h) do { _Pragma("unroll") for (int n = 0; n < 2; ++n) _Pragma("unroll") for (int k = 0; k < 2; ++k) dst[n][k] = *(const LAS bf16x8*)(lds + PG8_SB(b, h) + boff + n * 2048 + k * 1024); } while (0)
#define PG8_MMA(ai, bj, At, Bt) do { __builtin_amdgcn_s_setprio(1); _Pragma("unroll") for (int m = 0; m < 4; ++m) _Pragma("unroll") for (int n = 0; n < 2; ++n) _Pragma("unroll") for (int k = 0; k < 2; ++k) \
        acc[ai][bj][m][n] = __builtin_amdgcn_mfma_f32_16x16x32_bf16(Bt[n][k], At[m][k], acc[ai][bj][m][n], 0, 0, 0); __builtin_amdgcn_s_setprio(0); } while (0)
#define PG8_WAIT_V(n) asm volatile("s_waitcnt vmcnt(" #n ")" ::: "memory")
#define PG8_WAIT_L(n) asm volatile("s_waitcnt lgkmcnt(" #n ")" ::: "memory")
#define PG8_BAR __builtin_amdgcn_s_barrier()
#define PG8_SCHED __builtin_amdgcn_sched_barrier(0)
    Unit cur, nxt; int ui = 0;
    if (!S.next(0, cur)) return;
    f32x4 acc[2][2][4][2];
#pragma unroll
    for (int a = 0; a < 2; ++a)
#pragma unroll
        for (int b = 0; b < 2; ++b)
#pragma unroll
            for (int m = 0; m < 4; ++m)
#pragma unroll
                for (int n = 0; n < 2; ++n) acc[a][b][m][n] = (f32x4){0.f, 0.f, 0.f, 0.f};
    bf16x8 At[4][2], B0[2][2], B1[2][2];
    const char* cA = cur.a; const char* cB = cur.b;
    PG8_STAGE(PG8_SB(0, 0), cB, voffB); PG8_STAGE(PG8_SB(0, 1), cB + hstep, voffB); PG8_STAGE(PG8_SA(0, 0), cA, voffA); PG8_STAGE(PG8_SA(0, 1), cA + hstep, voffA);
    if (wr == 1) PG8_BAR;
    PG8_WAIT_V(2); PG8_BAR;
    PG8_STAGE(PG8_SB(1, 0), cB + kstep, voffB); PG8_STAGE(PG8_SA(1, 0), cA + kstep, voffA); PG8_STAGE(PG8_SB(1, 1), cB + hstep + kstep, voffB);
    PG8_WAIT_V(6); PG8_BAR;
    for (;;) {
        const bool has_next = S.next(ui + 1, nxt);
        const char* nA = has_next ? nxt.a : cA; const char* nB = has_next ? nxt.b : cB;
        for (int t = 0; t < nt; t += 2) {
            const bool last = (t == nt - 2);
            const char* a1 = cA + (size_t)(t + 1) * kstep;
            const char* a2 = last ? nA : cA + (size_t)(t + 2) * kstep; const char* b2 = last ? nB : cB + (size_t)(t + 2) * kstep;
            const char* a3 = a2 + kstep; const char* b3 = b2 + kstep;
            PG8_LDB(B0, 0, 0); PG8_LDB(B1, 0, 1); PG8_SCHED; PG8_LDA(At, 0, 0); PG8_STAGE(PG8_SA(1, 1), a1 + hstep, voffA);
            PG8_WAIT_V(8); PG8_WAIT_L(0); PG8_BAR; PG8_MMA(0, 0, At, B0); PG8_MMA(0, 1, At, B1); PG8_BAR; PG8_SCHED;
            PG8_LDA(At, 0, 1); PG8_STAGE(PG8_SB(0, 0), b2, voffB); PG8_STAGE(PG8_SB(0, 1), b2 + hstep, voffB); PG8_STAGE(PG8_SA(0, 0), a2, voffA);
            PG8_WAIT_V(8); PG8_WAIT_L(0); PG8_BAR; PG8_MMA(1, 0, At, B0); PG8_MMA(1, 1, At, B1); PG8_BAR; PG8_SCHED;
            PG8_LDB(B0, 1, 0); PG8_LDB(B1, 1, 1); PG8_SCHED; PG8_LDA(At, 1, 0); PG8_STAGE(PG8_SA(0, 1), a2 + hstep, voffA);
            PG8_WAIT_V(8); PG8_WAIT_L(0); PG8_BAR; PG8_MMA(0, 0, At, B0); PG8_MMA(0, 1, At, B1); PG8_BAR; PG8_SCHED;
            PG8_LDA(At, 1, 1); PG8_STAGE(PG8_SB(1, 0), b3, voffB); PG8_STAGE(PG8_SB(1, 1), b3 + hstep, voffB); PG8_STAGE(PG8_SA(1, 0), a3, voffA);
            PG8_WAIT_V(8); PG8_WAIT_L(0); PG8_BAR; PG8_MMA(1, 0, At, B0); PG8_MMA(1, 1, At, B1); PG8_BAR; PG8_SCHED;
        }
        if (wr == 0) PG8_BAR;
        E(acc, cur, wr, wc, fr, fq);
        if (!has_next) break;
#pragma unroll
        for (int a = 0; a < 2; ++a)
#pragma unroll
            for (int b = 0; b < 2; ++b)
#pragma unroll
                for (int m = 0; m < 4; ++m)
#pragma unroll
                    for (int n = 0; n < 2; ++n) acc[a][b][m][n] = (f32x4){0.f, 0.f, 0.f, 0.f};
        cur = nxt; cA = nA; cB = nB; ++ui;
        if (wr == 1) PG8_BAR;
    }
    PG8_WAIT_V(0);
    PG8_BAR;
#undef PG8_SA
#undef PG8_SB
#undef PG8_STAGE
#undef PG8_LDA
#undef PG8_LDB
#undef PG8_MMA
#undef PG8_WAIT_V
#undef PG8_WAIT_L
#undef PG8_BAR
#undef PG8_SCHED
}
}

struct Args { const float* in[14]; float* out; unsigned char* ws; int ph_lo, ph_hi; };

struct Ctx {
    const float *xp, *xs, *cp, *cs, *ada_w, *ada_b, *g_pre, *g_post, *w_in, *pool_w, *pool_scale, *dec_f, *dec_b, *w_out;
    float* out; unsigned char* ws;
    float* mod; bf16_t *WinT, *WoutT; float* part; bf16_t *H, *U, *Q, *Kb, *VT, *Z, *KV, *OUTB;
    int tid, lane, wave, G, bid;
};
__device__ __forceinline__ const float* x_row(const Ctx& F, int m) { return m < T_P ? F.xp + (size_t)m * DM : F.xs + (size_t)(m - T_P) * DM; }

__device__ __forceinline__ int colmap(int rho) {
    const int pn = rho >> 8;
    if (pn < 4 || pn >= 12) return rho;
    const int s = rho & 255, bj = s >> 7, sp = s & 127;
    return 1024 * (pn >> 2) + (2 * (pn & 3) + (sp >> 6)) * 128 + 64 * bj + (sp & 63);
}
__device__ __forceinline__ void p0_write_tile(bf16_t* WT, int Kdst, int row0, int k0, LAS float* scr, int lane) {
    asm volatile("s_waitcnt lgkmcnt(0)" ::: "memory");
    const int c = lane & 7;
#pragma unroll
    for (int j = 0; j < 4; ++j) { const int n = (lane >> 3) + 8 * j; const LAS float* s = scr + (8 * c) * 33 + n;
        u32x4 o; o.x = pk_bf16(s[0 * 33], s[1 * 33]); o.y = pk_bf16(s[2 * 33], s[3 * 33]); o.z = pk_bf16(s[4 * 33], s[5 * 33]); o.w = pk_bf16(s[6 * 33], s[7 * 33]);
        *(u32x4*)(WT + (size_t)(row0 + n) * Kdst + k0 + 8 * c) = o; }
    asm volatile("s_waitcnt lgkmcnt(0)" ::: "memory");
}
__device__ __forceinline__ void p0_transpose_item(const float* W, int N, int k0, int n0src, bf16_t* WT, int Kdst, int row0, LAS float* scr, int lane) {
#pragma unroll 8
    for (int i = 0; i < 32; ++i) { const int kk = 2 * i + (lane >> 5); scr[kk * 33 + (lane & 31)] = W[(size_t)(k0 + kk) * N + n0src + (lane & 31)]; }
    p0_write_tile(WT, Kdst, row0, k0, scr, lane);
}
__device__ __forceinline__ void p0_fold_item(const Ctx& F, int item, LAS float* scr, int lane) {
    const int kb = item >> 5, nb = item & 31, k0 = 64 * kb, rho0 = 32 * nb, g = rho0 >> 8, d0 = rho0 & 255;
    const int kl = lane >> 3, dg = lane & 7;
    f32x4 acc[8];
#pragma unroll
    for (int q = 0; q < 8; ++q) acc[q] = (f32x4){0.f, 0.f, 0.f, 0.f};
    const float* pw0 = F.pool_w + (size_t)g * 65536 + d0 + 4 * dg;
    const float* wi0 = F.w_in + (size_t)(k0 + kl) * DIN + g * 256;
#pragma unroll 4
    for (int c = 0; c < 256; c += 4) {
        f32x4 pw[4];
#pragma unroll
        for (int cc = 0; cc < 4; ++cc) pw[cc] = *(const f32x4*)(pw0 + (size_t)(c + cc) * 256);
#pragma unroll
        for (int q = 0; q < 8; ++q) { const f32x4 wv = *(const f32x4*)(wi0 + (size_t)(8 * q) * DIN + c);
            acc[q] += wv.x * pw[0] + wv.y * pw[1] + wv.z * pw[2] + wv.w * pw[3]; }
    }
#pragma unroll
    for (int q = 0; q < 8; ++q)
#pragma unroll
        for (int e = 0; e < 4; ++e) scr[(kl + 8 * q) * 33 + 4 * dg + e] = acc[q][e];
    p0_write_tile(F.WinT, DM, rho0, k0, scr, lane);
}
__device__ __forceinline__ void p0_prologue(const Ctx& F, LAS unsigned char* lds) {
    LAS float* scr = (LAS float*)(lds + F.wave * 16384);
    if (F.bid < 48) {
        LAS float* sv = scr; LAS float* red = (LAS float*)(lds + F.wave * 16384 + 12288);
        const int kw0 = 128 * F.wave;
        for (int idx = F.lane; idx < 2048; idx += 64) { const int r = idx >> 7, kk = idx & 127;
            const float c = r < 8 ? F.cp[r * DM + kw0 + kk] : F.cs[(r - 8) * DM + kw0 + kk]; sv[idx] = silu_f(c); }
        asm volatile("s_waitcnt lgkmcnt(0)" ::: "memory");
        float a16[16];
#pragma unroll
        for (int r = 0; r < 16; ++r) a16[r] = 0.f;
        const float* wp = F.ada_w + (size_t)kw0 * 3072 + 64 * F.bid + F.lane;
#pragma unroll 8
        for (int kk = 0; kk < 128; ++kk) { const float wv = wp[(size_t)kk * 3072];
#pragma unroll
            for (int r = 0; r < 16; ++r) a16[r] += sv[r * 128 + kk] * wv; }
#pragma unroll
        for (int r = 0; r < 16; ++r) red[r * 64 + F.lane] = a16[r];
        __syncthreads();
        for (int o = F.tid; o < 1024; o += NTHR) { const int r = o >> 6, col = o & 63; float s = F.ada_b[64 * F.bid + col];
#pragma unroll
            for (int w = 0; w < 8; ++w) s += *((LAS float*)(lds + w * 16384 + 12288) + r * 64 + col);
            F.mod[r * 3072 + 64 * F.bid + col] = s; }
    }
    const int gw = F.bid * NWAVES + F.wave, NGW = F.G * NWAVES;
    constexpr int I_FOLD = 512, I_IN = 16 * 160, I_OUT = 32 * 32;
    for (int it = gw; it < I_FOLD + I_IN + I_OUT; it += NGW) {
        int r = it;
        if (r < I_FOLD) { p0_fold_item(F, r, scr, F.lane); continue; } r -= I_FOLD;
        if (r < I_IN) { const int kb = r / 160, nb = r % 160, rho0 = 1024 + 32 * nb; p0_transpose_item(F.w_in, DIN, 64 * kb, colmap(rho0), F.WinT, DM, rho0, scr, F.lane); continue; } r -= I_IN;
        { const int kb = r >> 5, nb = r & 31; p0_transpose_item(F.w_out, DM, 64 * kb, 32 * nb, F.WoutT, DMIX, 32 * nb, scr, F.lane); }
    }
}

__device__ __forceinline__ void p1_prenorm(const Ctx& F) {
    const int gw = F.bid * NWAVES + F.wave, NGW = F.G * NWAVES;
    for (int gi = gw; gi < T_ALL / 16; gi += NGW) {
        const int m0 = gi * 16; int b16, pos; row_info(m0, b16, pos);
        const float* md = F.mod + b16 * 3072;
        f32x4 ga[4], sh[4];
#pragma unroll
        for (int j = 0; j < 4; ++j) { const int c = 4 * F.lane + 256 * j; const f32x4 g = *(const f32x4*)(F.g_pre + c), sc = *(const f32x4*)(md + 1024 + c);
            ga[j] = g * (sc + 1.0f); sh[j] = *(const f32x4*)(md + c); }
        for (int r = 0; r < 16; ++r) {
            const f32x4* xr = (const f32x4*)x_row(F, m0 + r) + F.lane;
            f32x4 v[4]; float s = 0.f;
#pragma unroll
            for (int j = 0; j < 4; ++j) { v[j] = xr[64 * j]; s += (v[j].x * v[j].x + v[j].y * v[j].y) + (v[j].z * v[j].z + v[j].w * v[j].w); }
            const float rstd = rsqrtf(wave_sum(s) * (1.f / DM) + EPS);
            u32x2* o8 = (u32x2*)(F.H + (size_t)(m0 + r) * DM) + F.lane;
#pragma unroll
            for (int j = 0; j < 4; ++j) { const f32x4 y = v[j] * rstd * ga[j] + sh[j]; u32x2 w; w.x = pk_bf16(y.x, y.y); w.y = pk_bf16(y.z, y.w); o8[64 * j] = w; }
        }
    }
}

struct SchedIn {
    const char* H; const char* W; int G, c;
    __device__ __forceinline__ bool next(int i, pg8::Unit& u) const {
        int pm, pn; if (!pg8::order_next(i, G, c, T_ALL / 256, DIN / 256, pm, pn)) return false;
        const size_t tstep = (size_t)256 * DM * 2; const char* hp = H + (size_t)pm * tstep; const char* wp = W + (size_t)pn * tstep;
        const bool sw = (pn >= 12 && pn < 16);
        u.a = sw ? wp : hp; u.b = sw ? hp : wp; u.pm = pm; u.pn = pn; return true;
    }
};
struct EpiIn {
    bf16_t *U, *Q, *Kb, *VT, *Z;
    __device__ __forceinline__ void operator()(const f32x4 (&acc)[2][2][4][2], const pg8::Unit& u, int wr, int wc, int fr, int fq) const {
        const int pm = u.pm, pn = u.pn;
        if (pn < 4) {
#pragma unroll
            for (int ai = 0; ai < 2; ++ai)
#pragma unroll
                for (int m = 0; m < 4; ++m) { bf16_t* rp = U + (size_t)(pm * 256 + ai * 128 + wr * 64 + m * 16 + fr) * DM + pn * 256 + wc * 32 + 8 * fq;
#pragma unroll
                    for (int bj = 0; bj < 2; ++bj) { const f32x4 v0 = acc[ai][bj][m][0], v1 = acc[ai][bj][m][1];
                        u32x4 w; w.x = pk_bf16(v0[0], v0[1]); w.y = pk_bf16(v0[2], v0[3]); w.z = pk_bf16(v1[0], v1[1]); w.w = pk_bf16(v1[2], v1[3]);
                        *(u32x4*)(rp + bj * 128) = w; } }
        } else if (pn < 12) {
            const bool isk = pn >= 8; bf16_t* base = isk ? Kb : Q; const float scl = isk ? 0.08838834764831845f : 1.0f;
            const int head = 2 * (pn & 3) + (wc >> 1), dlo = 32 * (wc & 1) + 8 * fq;
            const int pos0 = pm < 256 ? (pm & 31) * 256 : ((pm - 256) & 15) * 256;
            float cf[8];
#pragma unroll
            for (int e = 0; e < 8; ++e) cf[e] = __builtin_amdgcn_exp2f(-(float)(dlo + e) * 0.20762050593046014f) * 0.15915494309189535f;
#pragma unroll
            for (int ai = 0; ai < 2; ++ai)
#pragma unroll
                for (int m = 0; m < 4; ++m) {
                    const int rl = ai * 128 + wr * 64 + m * 16 + fr; const float fpos = (float)(pos0 + rl);
                    float o1[8], o2[8];
#pragma unroll
                    for (int e = 0; e < 8; ++e) {
                        const float rev = fpos * cf[e]; const float fr_ = __builtin_amdgcn_fractf(rev);
                        const float sn = __builtin_amdgcn_sinf(fr_), cs = __builtin_amdgcn_cosf(fr_);
                        const float x1 = acc[ai][0][m][e >> 2][e & 3], x2 = acc[ai][1][m][e >> 2][e & 3];
                        o1[e] = (x1 * cs - x2 * sn) * scl; o2[e] = (x2 * cs + x1 * sn) * scl;
                    }
                    bf16_t* rp = base + (size_t)(pm * 256 + rl) * DM + head * 128 + dlo;
                    u32x4 w1, w2; w1.x = pk_bf16(o1[0], o1[1]); w1.y = pk_bf16(o1[2], o1[3]); w1.z = pk_bf16(o1[4], o1[5]); w1.w = pk_bf16(o1[6], o1[7]);
                    w2.x = pk_bf16(o2[0], o2[1]); w2.y = pk_bf16(o2[2], o2[3]); w2.z = pk_bf16(o2[4], o2[5]); w2.w = pk_bf16(o2[6], o2[7]);
                    *(u32x4*)rp = w1; *(u32x4*)(rp + 64) = w2;
                }
        } else if (pn < 16) {
            int b, t0, S; size_t gbase;
            if (pm < 256) { b = pm >> 5; t0 = (pm & 31) * 256; S = S_P; gbase = 0; } else { const int q = pm - 256; b = q >> 4; t0 = (q & 15) * 256; S = S_S; gbase = (size_t)64 * 128 * S_P; }
#pragma unroll
            for (int ai = 0; ai < 2; ++ai)
#pragma unroll
                for (int m = 0; m < 4; ++m) { const int head = 2 * (pn - 12) + ai, dv = wr * 64 + m * 16 + fr;
                    bf16_t* rp = VT + gbase + ((size_t)(b * 8 + head) * 128 + dv) * S + t0 + wc * 32 + 8 * fq;
#pragma unroll
                    for (int bj = 0; bj < 2; ++bj) { const f32x4 v0 = acc[ai][bj][m][0], v1 = acc[ai][bj][m][1];
                        u32x4 w; w.x = pk_bf16(v0[0], v0[1]); w.y = pk_bf16(v0[2], v0[3]); w.z = pk_bf16(v1[0], v1[1]); w.w = pk_bf16(v1[2], v1[3]);
                        *(u32x4*)(rp + bj * 128) = w; } }
        } else {
#pragma unroll
            for (int ai = 0; ai < 2; ++ai)
#pragma unroll
                for (int m = 0; m < 4; ++m) { bf16_t* rp = Z + (size_t)(pm * 256 + ai * 128 + wr * 64 + m * 16 + fr) * DMIX + (pn - 16) * 256 + wc * 32 + 8 * fq;
#pragma unroll
                    for (int bj = 0; bj < 2; ++bj) { const f32x4 v0 = acc[ai][bj][m][0], v1 = acc[ai][bj][m][1];
                        u32x4 w; w.x = pk_bf16(silu_f(v0[0]), silu_f(v0[1])); w.y = pk_bf16(silu_f(v0[2]), silu_f(v0[3])); w.z = pk_bf16(silu_f(v1[0]), silu_f(v1[1])); w.w = pk_bf16(silu_f(v1[2]), silu_f(v1[3]));
                        *(u32x4*)(rp + bj * 128) = w; } }
        }
    }
};

struct RItem { int S, m0, h, nsc, sc; const bf16_t* vt; };
__device__ __forceinline__ RItem ritem(const Ctx& F, int it) {
    RItem r;
    if (it < 2048) { const int bh = it >> 5; r.sc = it & 31; r.S = S_P; r.nsc = 32; r.h = bh & 7; r.m0 = (bh >> 3) * S_P + r.sc * 256; r.vt = F.VT + (size_t)bh * 128 * S_P + r.sc * 256; }
    else { const int q = it - 2048, bh = q >> 4; r.sc = q & 15; r.S = S_S; r.nsc = 16; r.h = bh & 7; r.m0 = T_P + (bh >> 3) * S_S + r.sc * 256; r.vt = F.VT + (size_t)64 * 128 * S_P + (size_t)bh * 128 * S_S + r.sc * 256; }
    return r;
}
__device__ __forceinline__ float log2_gamma(const float* dec, int h) { return log1pf(-exp2f(-dec[h])) * 1.4426950408889634f; }

__device__ __forceinline__ void ra_item(const Ctx& F, int it, LAS unsigned char* lds) {
    const RItem R = ritem(F, it);
    const int tid = F.tid, w = F.wave, lane = F.lane, l15 = lane & 15, g = lane >> 4;
    LAS unsigned char* Kl = lds;
    LAS unsigned char* Vl = lds + 69632;
#pragma unroll
    for (int p = 0; p < 8; ++p) { const int idx = p * NTHR + tid, row = idx >> 4, c = idx & 15;
        const u32x4 v = *(const u32x4*)(F.Kb + (size_t)(R.m0 + row) * DM + R.h * 128 + c * 8);
        LAS u32x2* d = (LAS u32x2*)(Kl + row * 264 + c * 16); d[0] = (u32x2){v.x, v.y}; d[1] = (u32x2){v.z, v.w}; }
#pragma unroll
    for (int p = 0; p < 8; ++p) { const int idx = p * NTHR + tid, row = idx >> 5, c = idx & 31;
        const u32x4 v = *(const u32x4*)(R.vt + (size_t)row * R.S + c * 8);
        *(LAS u32x4*)(Vl + row * 528 + c * 16) = v; }
    __syncthreads();
    const int dir = w >> 2, dk0 = (w & 3) * 32;
    const float lg2 = log2_gamma(dir ? F.dec_b : F.dec_f, R.h);
    f32x4 acc[2][8];
#pragma unroll
    for (int mt = 0; mt < 2; ++mt)
#pragma unroll
        for (int nt = 0; nt < 8; ++nt) acc[mt][nt] = (f32x4){0.f, 0.f, 0.f, 0.f};
    const LAS bf16_t* Ks = (const LAS bf16_t*)Kl;
#pragma unroll 2
    for (int kk = 0; kk < 8; ++kk) {
        float wj[8];
#pragma unroll
        for (int e = 0; e < 8; ++e) { const int j = 32 * kk + 8 * g + e; wj[e] = __builtin_amdgcn_exp2f(lg2 * (float)(dir ? j : 255 - j)); }
        bf16x8 af[2];
#pragma unroll
        for (int mt = 0; mt < 2; ++mt) { const int dk = dk0 + 16 * mt + l15; float t[8];
#pragma unroll
            for (int e = 0; e < 8; ++e) t[e] = __uint_as_float((unsigned)Ks[(32 * kk + 8 * g + e) * 132 + dk] << 16) * wj[e];
            u32x4 pa; pa.x = pk_bf16(t[0], t[1]); pa.y = pk_bf16(t[2], t[3]); pa.z = pk_bf16(t[4], t[5]); pa.w = pk_bf16(t[6], t[7]);
            af[mt] = __builtin_bit_cast(bf16x8, pa); }
#pragma unroll
        for (int nt = 0; nt < 8; ++nt) { const bf16x8 bfr = *(const LAS bf16x8*)(Vl + (16 * nt + l15) * 528 + (32 * kk + 8 * g) * 2);
#pragma unroll
            for (int mt = 0; mt < 2; ++mt) acc[mt][nt] = __builtin_amdgcn_mfma_f32_16x16x32_bf16(af[mt], bfr, acc[mt][nt], 0, 0, 0); }
    }
    bf16_t* kv = F.KV + (size_t)it * 32768 + dir * 16384;
#pragma unroll
    for (int mt = 0; mt < 2; ++mt)
#pragma unroll
        for (int nt = 0; nt < 8; ++nt) { const f32x4 v = acc[mt][nt]; u32x2 o; o.x = pk_bf16(v[0], v[1]); o.y = pk_bf16(v[2], v[3]);
            *(u32x2*)(kv + (16 * nt + l15) * 128 + dk0 + 16 * mt + 4 * g) = o; }
    __syncthreads();
}

__device__ __forceinline__ void acc8(float (&s)[8], const u32x4 v, float sg) {
    s[0] += sg * bf_lo(v.x); s[1] += sg * bf_hi(v.x); s[2] += sg * bf_lo(v.y); s[3] += sg * bf_hi(v.y); s[4] += sg * bf_lo(v.z); s[5] += sg * bf_hi(v.z); s[6] += sg * bf_lo(v.w); s[7] += sg * bf_hi(v.w);
}
__device__ __forceinline__ void pool_item(const Ctx& F, int pt, LAS unsigned char* lds) {
    const int tid = F.tid, cg8 = tid & 127, tq = tid >> 7, ch = 8 * cg8, half = 1 << (cg8 >> 5);
    const int m0 = pt * 32; int b16, pos0; row_info(m0, b16, pos0);
    const int S = m0 < T_P ? S_P : S_S; const int mseq = m0 - pos0;
    const bf16_t* ub = F.U + (size_t)mseq * DM;
    u32x4 stg[12];
#pragma unroll
    for (int p = 0; p < 12; ++p) { const int idx = p * NTHR + tid, row = idx >> 7, c = idx & 127, pos = pos0 - 8 + row;
        stg[p] = (pos >= 0 && pos < S) ? *(const u32x4*)(ub + (size_t)pos * DM + c * 8) : (u32x4){0u, 0u, 0u, 0u}; }
    bf16_t* zp = F.Z + (size_t)(m0 + 8 * tq) * DMIX + ch;
    u32x4 zv[8];
#pragma unroll
    for (int r = 0; r < 8; ++r) zv[r] = *(const u32x4*)(zp + (size_t)r * DMIX);
#pragma unroll
    for (int p = 0; p < 12; ++p) { const int idx = p * NTHR + tid; *(LAS u32x4*)(lds + (idx >> 7) * 2048 + (idx & 127) * 16) = stg[p]; }
    __syncthreads();
    float ps[8];
    { const f32x4 a = *(const f32x4*)(F.pool_scale + ch), b = *(const f32x4*)(F.pool_scale + ch + 4); ps[0] = a.x; ps[1] = a.y; ps[2] = a.z; ps[3] = a.w; ps[4] = b.x; ps[5] = b.y; ps[6] = b.z; ps[7] = b.w; }
    const LAS unsigned char* col = lds + cg8 * 16;
    const int t0 = 8 * tq;
    float sum[8];
#pragma unroll
    for (int e = 0; e < 8; ++e) sum[e] = 0.f;
    for (int s2 = 0; s2 < 2 * half; ++s2) acc8(sum, *(const LAS u32x4*)(col + (t0 + 8 - half + s2) * 2048), 1.0f);
#pragma unroll
    for (int r = 0; r < 8; ++r) {
        const int t = t0 + r, pos = pos0 + t;
        if (r > 0) { acc8(sum, *(const LAS u32x4*)(col + (t + 7 + half) * 2048), 1.0f); acc8(sum, *(const LAS u32x4*)(col + (t + 7 - half) * 2048), -1.0f); }
        const int lo = max(pos - half, 0), hi = min(pos + half, S); const float inv = 1.0f / (float)(hi - lo);
        const u32x4 c = *(const LAS u32x4*)(col + (t + 8) * 2048), z = zv[r];
        float y[8];
        y[0] = (sum[0] * inv - bf_lo(c.x)) * ps[0] * bf_lo(z.x); y[1] = (sum[1] * inv - bf_hi(c.x)) * ps[1] * bf_hi(z.x);
        y[2] = (sum[2] * inv - bf_lo(c.y)) * ps[2] * bf_lo(z.y); y[3] = (sum[3] * inv - bf_hi(c.y)) * ps[3] * bf_hi(z.y);
        y[4] = (sum[4] * inv - bf_lo(c.z)) * ps[4] * bf_lo(z.z); y[5] = (sum[5] * inv - bf_hi(c.z)) * ps[5] * bf_hi(z.z);
        y[6] = (sum[6] * inv - bf_lo(c.w)) * ps[6] * bf_lo(z.w); y[7] = (sum[7] * inv - bf_hi(c.w)) * ps[7] * bf_hi(z.w);
        u32x4 o; o.x = pk_bf16(y[0], y[1]); o.y = pk_bf16(y[2], y[3]); o.z = pk_bf16(y[4], y[5]); o.w = pk_bf16(y[6], y[7]);
        *(u32x4*)(zp + (size_t)r * DMIX) = o;
    }
    __syncthreads();
}

__device__ __forceinline__ void rb_scan(const Ctx& F) {
    for (int q = F.bid; q < 1024; q += F.G) {
        const int seq = q >> 3, dir = (q >> 2) & 1, quarter = q & 3;
        const int nsc = seq < 64 ? 32 : 16, it0 = seq < 64 ? seq * 32 : 2048 + (seq - 64) * 16, h = seq & 7;
        const float Gd = __builtin_amdgcn_exp2f(256.0f * log2_gamma(dir ? F.dec_b : F.dec_f, h));
        bf16_t* base = F.KV + (size_t)it0 * 32768 + dir * 16384 + quarter * 4096 + F.tid * 8;
        float st[8];
#pragma unroll
        for (int e = 0; e < 8; ++e) st[e] = 0.f;
        for (int s0 = 0; s0 < nsc; s0 += 4) {
            u32x4 v[4];
#pragma unroll
            for (int u = 0; u < 4; ++u) { const int sc = dir ? nsc - 1 - (s0 + u) : s0 + u; v[u] = *(const u32x4*)(base + (size_t)sc * 32768); }
#pragma unroll
            for (int u = 0; u < 4; ++u) { const int sc = dir ? nsc - 1 - (s0 + u) : s0 + u;
                u32x4 o; o.x = pk_bf16(st[0], st[1]); o.y = pk_bf16(st[2], st[3]); o.z = pk_bf16(st[4], st[5]); o.w = pk_bf16(st[6], st[7]);
                *(u32x4*)(base + (size_t)sc * 32768) = o;
                st[0] = st[0] * Gd + bf_lo(v[u].x); st[1] = st[1] * Gd + bf_hi(v[u].x); st[2] = st[2] * Gd + bf_lo(v[u].y); st[3] = st[3] * Gd + bf_hi(v[u].y);
                st[4] = st[4] * Gd + bf_lo(v[u].z); st[5] = st[5] * Gd + bf_hi(v[u].z); st[6] = st[6] * Gd + bf_lo(v[u].w); st[7] = st[7] * Gd + bf_hi(v[u].w); }
        }
    }
}

__device__ __forceinline__ unsigned rc_voff(int lane, int v, unsigned pitch) { const int rsub = lane >> 4, cpos = lane & 15; return (unsigned)rsub * pitch + (unsigned)((cpos ^ (4 * v + rsub)) << 4); }
__device__ __forceinline__ void rc_issue_A(const Ctx& F, const RItem& R, int h2, LAS unsigned char* buf, int w, int lane) {
    const bool isk = w < 4; const unsigned pitch = isk ? 2048u : 2u * (unsigned)R.S;
    const char* ub = isk ? (const char*)(F.Kb + (size_t)(R.m0 + 128 * h2) * DM + R.h * 128) : (const char*)(R.vt + 128 * h2);
    LAS unsigned char* lb = buf + (isk ? 0 : 32768) + (w & 3) * 8192;
    unsigned vo[4];
#pragma unroll
    for (int v = 0; v < 4; ++v) vo[v] = rc_voff(lane, v, pitch);
#pragma unroll
    for (int i = 0; i < 8; ++i) {
        const int qq = 8 * (w & 3) + i;
        __builtin_amdgcn_global_load_lds((const unsigned*)(ub + (size_t)(4 * qq) * pitch + vo[i & 3]), (LAS unsigned*)(lb + i * 1024), 16, 0, 0);
    }
}
__device__ __forceinline__ void rc_issue_B(const Ctx& F, int it, LAS unsigned char* buf, int w, int lane) {
    const char* ub = (const char*)(F.KV + (size_t)it * 32768) + w * 8192;
    LAS unsigned char* lb = buf + w * 8192;
    unsigned vo[4];
#pragma unroll
    for (int v = 0; v < 4; ++v) vo[v] = rc_voff(lane, v, 256u);
#pragma unroll
    for (int i = 0; i < 8; ++i)
        __builtin_amdgcn_global_load_lds((const unsigned*)(ub + i * 1024 + vo[i & 3]), (LAS unsigned*)(lb + i * 1024), 16, 0, 0);
}
__device__ __forceinline__ void rc_load_q(const Ctx& F, const RItem& R, int w, int l15, int g, bf16x8 (&qf)[2][4]) {
#pragma unroll
    for (int n2 = 0; n2 < 2; ++n2)
#pragma unroll
        for (int kk = 0; kk < 4; ++kk) qf[n2][kk] = *(const bf16x8*)(F.Q + (size_t)(R.m0 + 32 * w + 16 * n2 + l15) * DM + R.h * 128 + 32 * kk + 8 * g);
}
__device__ __forceinline__ void rc_half(const LAS unsigned char* buf, const LAS float* tab, int h2, const bf16x8 (&qf)[2][4], f32x4 (&o)[8][2],
                                        const float (&fa)[2], const float (&ba)[2], const int (&irow)[2], int l15, int g) {
#pragma unroll 1
    for (int k2 = 0; k2 < 4; ++k2) {
        f32x4 s[2][2];
#pragma unroll
        for (int jj = 0; jj < 2; ++jj)
#pragma unroll
            for (int n2 = 0; n2 < 2; ++n2) s[jj][n2] = (f32x4){0.f, 0.f, 0.f, 0.f};
#pragma unroll
        for (int jj = 0; jj < 2; ++jj)
#pragma unroll
            for (int kk = 0; kk < 4; ++kk) { const bf16x8 a = *(const LAS bf16x8*)(buf + (16 * (2 * k2 + jj) + l15) * 256 + (((4 * kk + g) ^ l15) << 4));
#pragma unroll
                for (int n2 = 0; n2 < 2; ++n2) s[jj][n2] = __builtin_amdgcn_mfma_f32_16x16x32_bf16(a, qf[n2][kk], s[jj][n2], 0, 0, 0); }
        const int jb = 128 * h2 + 32 * k2 + 4 * g;
        f32x4 tf[2], tb[2];
#pragma unroll
        for (int jj = 0; jj < 2; ++jj) { tf[jj] = *(const LAS f32x4*)(tab + jb + 16 * jj); tb[jj] = *(const LAS f32x4*)(tab + 256 + jb + 16 * jj); }
        bf16x8 pf[2];
#pragma unroll
        for (int n2 = 0; n2 < 2; ++n2) { float p[8];
#pragma unroll
            for (int jj = 0; jj < 2; ++jj)
#pragma unroll
                for (int r = 0; r < 4; ++r) { const int j = jb + 16 * jj + r; const float d = (j <= irow[n2]) ? fa[n2] * tf[jj][r] : ba[n2] * tb[jj][r]; p[4 * jj + r] = s[jj][n2][r] * d; }
            u32x4 pp; pp.x = pk_bf16(p[0], p[1]); pp.y = pk_bf16(p[2], p[3]); pp.z = pk_bf16(p[4], p[5]); pp.w = pk_bf16(p[6], p[7]);
            pf[n2] = __builtin_bit_cast(bf16x8, pp); }
#pragma unroll
        for (int mt = 0; mt < 8; ++mt) { const LAS unsigned char* vp = buf + 32768 + (16 * mt + l15) * 256 + 8 * (g & 1); const int c0 = 4 * k2 + (g >> 1);
            const u32x2 lo = *(const LAS u32x2*)(vp + ((c0 ^ l15) << 4)), hi = *(const LAS u32x2*)(vp + (((c0 + 2) ^ l15) << 4));
            const bf16x8 a = __builtin_bit_cast(bf16x8, (u32x4){lo.x, lo.y, hi.x, hi.y});
#pragma unroll
            for (int n2 = 0; n2 < 2; ++n2) o[mt][n2] = __builtin_amdgcn_mfma_f32_16x16x32_bf16(a, pf[n2], o[mt][n2], 0, 0, 0);
            if (mt & 1) __builtin_amdgcn_sched_barrier(0); }
    }
}
#define RC_WAIT_BAR() do { asm volatile("s_waitcnt vmcnt(0)" ::: "memory"); __syncthreads(); } while (0)
__device__ __forceinline__ void rc_phase(const Ctx& F, LAS unsigned char* lds) {
    const int tid = F.tid, w = F.wave;
    const int nitems = (3072 - F.bid + F.G - 1) / F.G;
    if (nitems <= 0) return;
    LAS float* tabs = (LAS float*)(lds + 131072);
    RItem R = ritem(F, F.bid);
    bf16x8 qf[2][4];
    rc_issue_A(F, R, 0, lds, w, F.lane);
    rc_load_q(F, R, w, F.lane & 15, F.lane >> 4, qf);
    for (int n = 0; n < nitems; ++n) {
        int lane_o = F.lane; asm volatile("" : "+v"(lane_o));
        const int lane = lane_o, l15 = lane & 15, g = lane >> 4;
        const int it = F.bid + n * F.G, par = n & 1;
        LAS unsigned char* b0 = lds + par * 65536; LAS unsigned char* b1 = lds + (par ^ 1) * 65536;
        LAS float* tab = tabs + par * 512;
        const float lg2f = log2_gamma(F.dec_f, R.h), lg2b = log2_gamma(F.dec_b, R.h);
        tab[tid] = tid < 256 ? __builtin_amdgcn_exp2f(-lg2f * (float)tid) : __builtin_amdgcn_exp2f(lg2b * (float)(tid - 256));
        float fa[2], ba[2]; int irow[2];
#pragma unroll
        for (int n2 = 0; n2 < 2; ++n2) { irow[n2] = 32 * w + 16 * n2 + l15; fa[n2] = __builtin_amdgcn_exp2f(lg2f * (float)irow[n2]); ba[n2] = __builtin_amdgcn_exp2f(-lg2b * (float)irow[n2]); }
        f32x4 o[8][2];
#pragma unroll
        for (int mt = 0; mt < 8; ++mt)
#pragma unroll
            for (int n2 = 0; n2 < 2; ++n2) o[mt][n2] = (f32x4){0.f, 0.f, 0.f, 0.f};
        RC_WAIT_BAR();
        rc_issue_A(F, R, 1, b1, w, lane);
        rc_half(b0, tab, 0, qf, o, fa, ba, irow, l15, g);
        RC_WAIT_BAR();
        rc_issue_B(F, it, b0, w, lane);
        rc_half(b1, tab, 1, qf, o, fa, ba, irow, l15, g);
        RC_WAIT_BAR();
        const bool more = (n + 1 < nitems);
        RItem Rn = R;
        if (more) { Rn = ritem(F, it + F.G); rc_issue_A(F, Rn, 0, b1, w, lane); }
        {
            float qfd[2], qbd[2];
#pragma unroll
            for (int n2 = 0; n2 < 2; ++n2) { qfd[n2] = __builtin_amdgcn_exp2f(lg2f * (float)(irow[n2] + 1)); qbd[n2] = __builtin_amdgcn_exp2f(lg2b * (float)(256 - irow[n2])); }
#pragma unroll
            for (int mt = 0; mt < 8; ++mt) {
                f32x4 tf[2], tb[2];
#pragma unroll
                for (int n2 = 0; n2 < 2; ++n2) { tf[n2] = (f32x4){0.f, 0.f, 0.f, 0.f}; tb[n2] = (f32x4){0.f, 0.f, 0.f, 0.f}; }
#pragma unroll
                for (int kk = 0; kk < 4; ++kk) { const LAS unsigned char* sp = b0 + (16 * mt + l15) * 256 + (((4 * kk + g) ^ l15) << 4);
                    const bf16x8 af = *(const LAS bf16x8*)sp, ab = *(const LAS bf16x8*)(sp + 32768);
#pragma unroll
                    for (int n2 = 0; n2 < 2; ++n2) { tf[n2] = __builtin_amdgcn_mfma_f32_16x16x32_bf16(af, qf[n2][kk], tf[n2], 0, 0, 0); tb[n2] = __builtin_amdgcn_mfma_f32_16x16x32_bf16(ab, qf[n2][kk], tb[n2], 0, 0, 0); } }
#pragma unroll
                for (int n2 = 0; n2 < 2; ++n2) o[mt][n2] += tf[n2] * qfd[n2] + tb[n2] * qbd[n2];
                __builtin_amdgcn_sched_barrier(0);
            }
        }
        bf16_t* zbase = F.Z + (size_t)(R.m0 + 32 * w + l15) * DMIX + 1024 + R.h * 128 + 4 * g;
        if (more) { R = Rn; rc_load_q(F, R, w, l15, g, qf); }
#pragma unroll
        for (int n2 = 0; n2 < 2; ++n2) {
            float s1 = 0.f;
#pragma unroll
            for (int mt = 0; mt < 8; ++mt) s1 += (o[mt][n2][0] + o[mt][n2][1]) + (o[mt][n2][2] + o[mt][n2][3]);
            s1 += __shfl_xor(s1, 16); s1 += __shfl_xor(s1, 32);
            const float mu = s1 * (1.0f / 128.0f); float s2 = 0.f;
#pragma unroll
            for (int mt = 0; mt < 8; ++mt) { const f32x4 d = o[mt][n2] - mu; s2 += (d[0] * d[0] + d[1] * d[1]) + (d[2] * d[2] + d[3] * d[3]); }
            s2 += __shfl_xor(s2, 16); s2 += __shfl_xor(s2, 32);
            const float rs = rsqrtf(s2 * (1.0f / 128.0f) + EPS);
            bf16_t* zp = zbase + (size_t)(16 * n2) * DMIX;
#pragma unroll
            for (int mt = 0; mt < 8; ++mt) { const u32x2 z = *(const u32x2*)(zp + 16 * mt); const f32x4 d = (o[mt][n2] - mu) * rs;
                u32x2 ov; ov.x = pk_bf16(d[0] * bf_lo(z.x), d[1] * bf_hi(z.x)); ov.y = pk_bf16(d[2] * bf_lo(z.y), d[3] * bf_hi(z.y));
                *(u32x2*)(zp + 16 * mt) = ov; }
        }
    }
    RC_WAIT_BAR();
}

struct SchedOut {
    const char* Y; const char* W; int G, c;
    __device__ __forceinline__ bool next(int i, pg8::Unit& u) const {
        int pm, pn; if (!pg8::order_next(i, G, c, T_ALL / 256, DM / 256, pm, pn)) return false;
        const size_t tstep = (size_t)256 * DMIX * 2; u.a = Y + (size_t)pm * tstep; u.b = W + (size_t)pn * tstep; u.pm = pm; u.pn = pn; return true;
    }
};
struct EpiOut {
    bf16_t* O; float* part;
    __device__ __forceinline__ void operator()(const f32x4 (&acc)[2][2][4][2], const pg8::Unit& u, int wr, int wc, int fr, int fq) const {
#pragma unroll
        for (int ai = 0; ai < 2; ++ai)
#pragma unroll
            for (int m = 0; m < 4; ++m) { const size_t row = (size_t)(u.pm * 256 + ai * 128 + wr * 64 + m * 16 + fr); bf16_t* rp = O + row * DM + u.pn * 256 + wc * 32 + 8 * fq; float ss = 0.f;
#pragma unroll
                for (int bj = 0; bj < 2; ++bj) { const f32x4 v0 = acc[ai][bj][m][0], v1 = acc[ai][bj][m][1];
                    ss += (v0[0] * v0[0] + v0[1] * v0[1]) + (v0[2] * v0[2] + v0[3] * v0[3]) + (v1[0] * v1[0] + v1[1] * v1[1]) + (v1[2] * v1[2] + v1[3] * v1[3]);
                    u32x4 w; w.x = pk_bf16(v0[0], v0[1]); w.y = pk_bf16(v0[2], v0[3]); w.z = pk_bf16(v1[0], v1[1]); w.w = pk_bf16(v1[2], v1[3]);
                    *(u32x4*)(rp + bj * 128) = w; }
                ss += __shfl_xor(ss, 16); ss += __shfl_xor(ss, 32);
                if (fq == 0) part[row * 16 + u.pn * 4 + wc] = ss; }
    }
};

__device__ __forceinline__ void p7_final(const Ctx& F) {
    const int gw = F.bid * NWAVES + F.wave, NGW = F.G * NWAVES;
    for (int gi = gw; gi < T_ALL / 16; gi += NGW) {
        const int m0 = gi * 16; int b16, pos; row_info(m0, b16, pos);
        const float* md = F.mod + b16 * 3072 + 2048;
        f32x4 gg[4];
#pragma unroll
        for (int j = 0; j < 4; ++j) { const int c = 4 * F.lane + 256 * j; gg[j] = *(const f32x4*)(F.g_post + c) * *(const f32x4*)(md + c); }
        for (int r = 0; r < 16; ++r) {
            const int m = m0 + r;
            float ss = F.part[(size_t)m * 16 + (F.lane & 15)];
            ss += __shfl_xor(ss, 1); ss += __shfl_xor(ss, 2); ss += __shfl_xor(ss, 4); ss += __shfl_xor(ss, 8);
            const float rstd = rsqrtf(ss * (1.f / DM) + EPS);
            const f32x4* xr = (const f32x4*)x_row(F, m) + F.lane;
            const u32x2* orow = (const u32x2*)(F.OUTB + (size_t)m * DM) + F.lane;
            f32x4* dst = (f32x4*)(F.out + (size_t)m * DM) + F.lane;
#pragma unroll
            for (int j = 0; j < 4; ++j) { const u32x2 ov = orow[64 * j]; const f32x4 xv = xr[64 * j];
                f32x4 y; y.x = xv.x + gg[j].x * (bf_lo(ov.x) * rstd); y.y = xv.y + gg[j].y * (bf_hi(ov.x) * rstd); y.z = xv.z + gg[j].z * (bf_lo(ov.y) * rstd); y.w = xv.w + gg[j].w * (bf_hi(ov.y) * rstd);
                dst[64 * j] = y; }
        }
    }
}

#ifndef PROBE_DUP
#define PROBE_DUP 0
#endif
#define XB_TMO      128
#define XB_XCNT(j)  (256  + 64 * (j))
#define XB_XSUB(j)  (1280 + 64 * (j))
#define XB_XGEN(j)  (2304 + 64 * (j))
#define XB_TOP      3328
#define XB_TOPGEN   3392
#define XCD_BAR_WORDS 3456
#define XB_SPIN_CAP (1u << 18)

__device__ __forceinline__ unsigned xb_ld(unsigned* p)              { return __hip_atomic_load(p, __ATOMIC_RELAXED, __HIP_MEMORY_SCOPE_AGENT); }
__device__ __forceinline__ unsigned xb_add(unsigned* p, unsigned v) { return __hip_atomic_fetch_add(p, v, __ATOMIC_RELAXED, __HIP_MEMORY_SCOPE_AGENT); }
__device__ __forceinline__ unsigned xb_xcc_id() { return (unsigned)__builtin_amdgcn_s_getreg((3 << 11) | 20) & 0xFu; }
#define XB_SPIN(cond, bar) do { unsigned _sp = 0; while (cond) { __builtin_amdgcn_s_sleep(1); \
    if ((++_sp & 255u) == 0u) { if (xb_ld(&(bar)[XB_TMO])) break; if (_sp > XB_SPIN_CAP) { atomicAdd(&(bar)[XB_TMO], 1u); break; } } } } while (0)

struct XcdBarrier {
    unsigned* bar; unsigned x;
    volatile LAS unsigned* st;
};

__device__ __forceinline__ XcdBarrier xcd_barrier_post(unsigned* bar, volatile LAS unsigned* st) {
    XcdBarrier b; b.bar = bar; b.x = xb_xcc_id(); b.st = st;
    if (threadIdx.x == 0) (void)xb_add(&bar[XB_XCNT(b.x)], 1u);
    return b;
}
__device__ __forceinline__ void xcd_barrier_complete(unsigned* bar, unsigned x, unsigned& nloc, unsigned& nx) {
    const unsigned G = gridDim.x * gridDim.y * gridDim.z;
    unsigned sum, cnt, mine, sp = 0u;
    for (;;) {
        sum = 0u; cnt = 0u; mine = 0u;
#pragma unroll
        for (unsigned j = 0; j < 16; ++j) { const unsigned c = xb_ld(&bar[XB_XCNT(j)]); sum += c; cnt += (c > 0u) ? 1u : 0u; mine = (j == x) ? c : mine; }
        if (sum == G) break;
        __builtin_amdgcn_s_sleep(1);
        if ((++sp & 255u) == 0u) { if (xb_ld(&bar[XB_TMO])) break; if (sp > XB_SPIN_CAP) { atomicAdd(&bar[XB_TMO], 1u); break; } }
    }
    nloc = mine > 0u ? mine : 1u; nx = cnt > 0u ? cnt : 1u;
}

__device__ __forceinline__ void xcd_barrier(const XcdBarrier& b) {
    asm volatile("s_waitcnt vmcnt(0)" ::: "memory");
    __syncthreads();
    if (threadIdx.x == 0) {
        unsigned* bar = b.bar;
        __builtin_amdgcn_s_waitcnt(0);
        unsigned nloc = b.st[0], nx = b.st[1];
        if (nloc == 0u) { xcd_barrier_complete(bar, b.x, nloc, nx); b.st[0] = nloc; b.st[1] = nx; }
        const unsigned old = xb_add(&bar[XB_XSUB(b.x)], 1u);
        const unsigned gen = old / nloc;
        if (old + 1u == (gen + 1u) * nloc) {
            __builtin_amdgcn_fence(__ATOMIC_RELEASE, "agent");
            asm volatile("s_waitcnt vmcnt(0)" ::: "memory");
            const unsigned og = xb_add(&bar[XB_TOP], 1u);
            const unsigned tg = og / nx;
            if (og + 1u == (tg + 1u) * nx) xb_add(&bar[XB_TOPGEN], 1u);
            else XB_SPIN(xb_ld(&bar[XB_TOPGEN]) == tg, bar);
            __builtin_amdgcn_fence(__ATOMIC_ACQUIRE, "agent");
            xb_add(&bar[XB_XGEN(b.x)], 1u);
            asm volatile("s_waitcnt vmcnt(0)" ::: "memory");
        } else {
            XB_SPIN(xb_ld(&bar[XB_XGEN(b.x)]) == gen, bar);
            __builtin_amdgcn_fence(__ATOMIC_ACQUIRE, "agent");
            asm volatile("s_waitcnt vmcnt(0)" ::: "memory");
        }
    }
    __syncthreads();
}

__global__ void __launch_bounds__(NTHR, 2) fwd_megakernel(Args args) {
    extern __shared__ __attribute__((aligned(16))) unsigned char smem[];
    cg::grid_group grid = cg::this_grid();
    LAS unsigned char* lds = (LAS unsigned char*)smem;
    Ctx F;
    F.xp = args.in[0]; F.xs = args.in[1]; F.cp = args.in[2]; F.cs = args.in[3]; F.ada_w = args.in[4]; F.ada_b = args.in[5]; F.g_pre = args.in[6]; F.g_post = args.in[7];
    F.w_in = args.in[8]; F.pool_w = args.in[9]; F.pool_scale = args.in[10]; F.dec_f = args.in[11]; F.dec_b = args.in[12]; F.w_out = args.in[13];
    F.out = args.out; F.ws = args.ws;
    F.mod = (float*)(args.ws + WS_MOD); F.WinT = (bf16_t*)(args.ws + WS_WIN); F.WoutT = (bf16_t*)(args.ws + WS_WOUT); F.part = (float*)(args.ws + WS_PART);
    F.H = (bf16_t*)(args.ws + WS_H); F.U = (bf16_t*)(args.ws + WS_U); F.Q = (bf16_t*)(args.ws + WS_Q); F.Kb = (bf16_t*)(args.ws + WS_K); F.VT = (bf16_t*)(args.ws + WS_VT);
    F.Z = (bf16_t*)args.out; F.KV = (bf16_t*)(args.ws + WS_H); F.OUTB = (bf16_t*)(args.ws + WS_U);
    F.tid = threadIdx.x; F.lane = F.tid & 63; F.wave = __builtin_amdgcn_readfirstlane(F.tid >> 6); F.G = gridDim.x; F.bid = blockIdx.x;
    const int lo = args.ph_lo, hi = args.ph_hi;
#define IN(k) (lo <= (k) && (k) < hi)
    volatile LAS unsigned* bst = (volatile LAS unsigned*)(lds + LDS_BYTES - 64);
    unsigned* barw = (unsigned*)(args.ws + WS_BAR);
    if (F.tid < 2) bst[F.tid] = 0u;
    if (F.bid == 0) for (int i = F.tid; i < XCD_BAR_WORDS; i += NTHR) barw[i] = 0u;
    __syncthreads();
    if (IN(0)) { p0_prologue(F, lds); }
    grid.sync();
    const XcdBarrier xbar = xcd_barrier_post(barw, bst);
#define SEAM(k) do { xcd_barrier(xbar); } while (0)
    if (IN(1)) { p1_prenorm(F); if (PROBE_DUP == 11) p1_prenorm(F); } SEAM(1);
    if (IN(2)) { for (int rep = 0; rep < (PROBE_DUP == 2 ? 2 : 1); ++rep) { SchedIn S{(const char*)F.H, (const char*)F.WinT, F.G, F.bid}; EpiIn E{F.U, F.Q, F.Kb, F.VT, F.Z}; pg8::gemm_phase<EpiIn, SchedIn>(lds, DM, S, E); } } SEAM(2);
    if (IN(3)) {
        for (int it = F.bid; it < 3072; it += F.G) ra_item(F, it, lds);
        for (int pt = F.bid; pt < T_ALL / 32; pt += F.G) pool_item(F, pt, lds);
    } SEAM(3);
    if (IN(4)) { rb_scan(F); } SEAM(4);
    if (IN(5)) { rc_phase(F, lds); } SEAM(5);
    if (IN(6)) { for (int rep = 0; rep < (PROBE_DUP == 6 ? 2 : 1); ++rep) { SchedOut S{(const char*)F.Z, (const char*)F.WoutT, F.G, F.bid}; EpiOut E{F.OUTB, F.part}; pg8::gemm_phase<EpiOut, SchedOut>(lds, DMIX, S, E); } } SEAM(6);
    if (IN(7)) { p7_final(F); if (PROBE_DUP == 17) p7_final(F); }
}

#ifndef N_LAUNCH_MODE
#define N_LAUNCH_MODE 1
#endif

extern "C" void kernel_launch(void* const* d_in, const int* in_sizes, int n_in, void* d_out, int out_size, void* d_ws, size_t ws_size, hipStream_t stream) {
    static int grid = 0;
    if (grid == 0) {
        if (n_in != 14 || out_size != T_ALL * DM || ws_size < WS_END) { fprintf(stderr, "kernel_launch: unexpected shapes (n_in %d out %d ws %zu)\n", n_in, out_size, ws_size); grid = -1; return; }
        int dev = 0, cus = 0, per_cu = 0;
        hipGetDevice(&dev); hipDeviceGetAttribute(&cus, hipDeviceAttributeMultiprocessorCount, dev);
        if (hipFuncSetAttribute((const void*)fwd_megakernel, hipFuncAttributeMaxDynamicSharedMemorySize, LDS_BYTES) != hipSuccess) { fprintf(stderr, "kernel_launch: hipFuncSetAttribute failed\n"); grid = -1; return; }
        if (hipOccupancyMaxActiveBlocksPerMultiprocessor(&per_cu, (const void*)fwd_megakernel, NTHR, LDS_BYTES) != hipSuccess || per_cu < 1) { fprintf(stderr, "kernel_launch: occupancy query says %d\n", per_cu); per_cu = 1; }
        (void)hipGetLastError();
        grid = cus * per_cu;
        fprintf(stderr, "kernel_launch: cus %d per_cu %d grid %d\n", cus, per_cu, grid);
    }
    if (grid < 0) return;
    Args a{};
    for (int i = 0; i < 14; ++i) a.in[i] = (const float*)d_in[i];
    a.out = (float*)d_out; a.ws = (unsigned char*)d_ws;
#if N_LAUNCH_MODE == 1
    a.ph_lo = 0; a.ph_hi = 8;
    void* kargs[] = {&a};
    hipError_t e = hipLaunchCooperativeKernel((const void*)fwd_megakernel, dim3(grid), dim3(NTHR), kargs, LDS_BYTES, stream);
    if (e != hipSuccess) fprintf(stderr, "kernel_launch: cooperative launch failed: %s (grid %d)\n", hipGetErrorString(e), grid);
#else
    for (int p = 0; p < 8; ++p) { a.ph_lo = p; a.ph_hi = p + 1; hipLaunchKernelGGL(fwd_megakernel, dim3(grid), dim3(NTHR), LDS_BYTES, stream, a); }
#endif
}
```
